# Optimizing an MI355X kernel written in HIP

```python
import math
import jax, jax.numpy as jnp
from jax import lax
import numpy as np

D_MODEL = 2048
BATCH = 2
SEQ = 4096
DEPTH = 2
DEC_BATCH = 8
DEC_SEQ = 1
PAST_LEN = 16384
PAGE_SIZE = 128

HEAD_DIM = 64
HEADS_PER_GROUP = 4
ATTN_GROUPS = ((128, 1), (512, 4), (2048, 16))
N_ATTN_GROUPS = len(ATTN_GROUPS)
N_HEADS = N_ATTN_GROUPS * HEADS_PER_GROUP
ATTN_WIDTH = N_HEADS * HEAD_DIM
ATTN_OUT = HEADS_PER_GROUP * HEAD_DIM
N_DIL_KEYS = 128
N_BUCKETS = 32
MAX_DISTANCE = 2048
ATTN_SCALE = HEAD_DIM ** -0.5
POOL_WINDOWS = (2, 4, 8, 16)
POOL_GROUP = D_MODEL // 16
POOL_WIDTH = len(POOL_WINDOWS) * POOL_GROUP
POOL_STATE = max(POOL_WINDOWS) - 1
CONV_CH = D_MODEL // 4
CONV_K = 3
D_FF = 5632
FFN_CONV_K = 3
N_BRANCH = 3
N_IN = 3 * ATTN_WIDTH + POOL_WIDTH + 3 * CONV_CH + N_BRANCH * D_MODEL
SPLITS = (ATTN_WIDTH, 2 * ATTN_WIDTH, 3 * ATTN_WIDTH,
          3 * ATTN_WIDTH + POOL_WIDTH,
          3 * ATTN_WIDTH + POOL_WIDTH + CONV_CH,
          3 * ATTN_WIDTH + POOL_WIDTH + 2 * CONV_CH,
          3 * ATTN_WIDTH + POOL_WIDTH + 3 * CONV_CH)
N_MOD = 6
EPS = 1e-6
NEG_INF = -1e30

kernel_name = 'gated_hybrid_pool_conv_dilated_attn_step'


def rms_norm(x, g):
    xf = x.astype(jnp.float32)
    y = xf * lax.rsqrt(jnp.mean(xf * xf, axis=-1, keepdims=True) + EPS)
    return (y * g.astype(jnp.float32)).astype(x.dtype)


def causal_dwconv(u_ext, w):
    k = w.shape[0]
    n = u_ext.shape[1] - (k - 1)
    return sum(u_ext[:, i:i + n] * w[i] for i in range(k))


def group_rel_bias(rel_bias):
    n = np.arange(N_DIL_KEYS + 1)
    max_exact = N_BUCKETS // 2
    out = []
    for g, (_, d) in enumerate(ATTN_GROUPS):
        dist = n * d
        large = max_exact + (np.log(np.maximum(dist, 1) / max_exact) / math.log(MAX_DISTANCE / max_exact)
                             * (N_BUCKETS - max_exact)).astype(np.int32)
        bucket = np.where(dist < max_exact, dist, np.minimum(large, N_BUCKETS - 1))
        out.append(rel_bias[bucket, g * HEADS_PER_GROUP:(g + 1) * HEADS_PER_GROUP].T)
    return jnp.stack(out)


def dilated_band_attention(q, k, v, bias, dilation):
    b, s, h, dh = q.shape
    n = N_DIL_KEYS
    L = s // dilation
    nb = -(-L // n)
    lp = nb * n

    def split(t):
        t = t.reshape(b, L, dilation, h, dh).transpose(0, 2, 1, 3, 4)
        return jnp.pad(t, ((0, 0), (0, 0), (0, lp - L), (0, 0), (0, 0)))

    def kblocks(t):
        t = jnp.pad(split(t), ((0, 0), (0, 0), (n, 0), (0, 0), (0, 0))).reshape(b, dilation, nb + 1, n, h, dh)
        return jnp.concatenate([t[:, :, :-1], t[:, :, 1:]], axis=3)

    qs = split(q).reshape(b, dilation, nb, n, h, dh)
    kb, vb = kblocks(k), kblocks(v)
    a_idx = np.arange(n)[:, None]
    c_idx = np.arange(2 * n)[None, :]
    dist = a_idx + n - c_idx
    band = (dist >= 0) & (dist <= n)
    key_idx = np.arange(nb)[:, None] * n - n + np.arange(2 * n)[None, :]
    valid = band[None] & (key_idx >= 0)[:, None, :]
    bias_qk = bias[:, np.clip(dist, 0, n)].astype(jnp.float32)
    s_ = jnp.einsum('brnqhd,brnkhd->brnhqk', qs, kb, preferred_element_type=jnp.float32) * ATTN_SCALE
    s_ = jnp.where(valid[None, None, :, None], s_ + bias_qk, NEG_INF)
    m = jnp.max(s_, axis=-1, keepdims=True)
    p = jnp.exp(s_ - m)
    l = jnp.sum(p, axis=-1, keepdims=True)
    o = jnp.einsum('brnhqk,brnkhd->brnqhd', (p / l).astype(v.dtype), vb)
    lse = (m + jnp.log(l))[..., 0]
    o = o.reshape(b, dilation, lp, h, dh)[:, :, :L].transpose(0, 2, 1, 3, 4).reshape(b, s, h, dh)
    lse = lse.transpose(0, 1, 2, 4, 3).reshape(b, dilation, lp, h)[:, :, :L].transpose(0, 2, 1, 3).reshape(b, s, h)
    return o, lse


def dilated_cache_attention(q, k_ext, v_ext, bias, dilation, n_past):
    t = q.shape[1]
    idx = n_past + np.arange(t)[:, None] - dilation * np.arange(N_DIL_KEYS + 1)[None, :]
    valid = idx >= 0
    idx = np.maximum(idx, 0)
    kg, vg = k_ext[:, idx], v_ext[:, idx]
    s_ = jnp.einsum('bthd,btnhd->bhtn', q, kg, preferred_element_type=jnp.float32) * ATTN_SCALE
    s_ = jnp.where(valid[None, None], s_ + bias[:, None, :].astype(jnp.float32), NEG_INF)
    m = jnp.max(s_, axis=-1, keepdims=True)
    p = jnp.exp(s_ - m)
    l = jnp.sum(p, axis=-1, keepdims=True)
    o = jnp.einsum('bhtn,btnhd->bthd', (p / l).astype(v_ext.dtype), vg)
    lse = (m + jnp.log(l))[..., 0].transpose(0, 2, 1)
    return o, lse


def combine_groups(outs, lses):
    o = jnp.stack(outs, axis=2)
    wgt = jax.nn.softmax(jnp.stack(lses, axis=2), axis=2)
    return jnp.einsum('btgh,btghd->bthd', wgt.astype(o.dtype), o)


def pool_prompt(p):
    _, s, _ = p.shape
    cs = jnp.pad(jnp.cumsum(p.astype(jnp.float32), axis=1), ((0, 0), (1, 0), (0, 0)))
    t = np.arange(s)
    means = []
    for gi, w in enumerate(POOL_WINDOWS):
        lo = np.maximum(t + 1 - w, 0)
        cg = cs[..., gi * POOL_GROUP:(gi + 1) * POOL_GROUP]
        cnt = (t + 1 - lo).astype(np.float32)
        means.append((cg[:, t + 1] - cg[:, lo]) / cnt[None, :, None])
    return jnp.concatenate(means, axis=-1) - p.astype(jnp.float32)


def pool_step(state, p):
    ext = jnp.concatenate([state, p], axis=1)
    cs = jnp.pad(jnp.cumsum(ext.astype(jnp.float32), axis=1), ((0, 0), (1, 0), (0, 0)))
    m = POOL_STATE + np.arange(p.shape[1])
    means = []
    for gi, w in enumerate(POOL_WINDOWS):
        cg = cs[..., gi * POOL_GROUP:(gi + 1) * POOL_GROUP]
        means.append((cg[:, m + 1] - cg[:, m + 1 - w]) / w)
    return jnp.concatenate(means, axis=-1) - p.astype(jnp.float32), ext[:, -POOL_STATE:]


def run_layer(x, c, lw, bias_g, hist):
    (norm_g, w_ada, b_ada, w_in, w_attn_br, w_pool_grp, pool_scale, w_pool_br,
     conv_w, w_conv_br, w_o, w_up, ffn_conv_w, w_down) = lw
    nb, t, _ = x.shape
    mod = (jax.nn.silu(c) @ w_ada + b_ada).reshape(nb, N_MOD, 1, D_MODEL)
    h = rms_norm(x, norm_g[0]) * (1 + mod[:, 1]) + mod[:, 0]
    q, k, v, p, gb, gc, hc, gl = jnp.split(h @ w_in, SPLITS, axis=-1)
    hs = (nb, t, N_ATTN_GROUPS, HEADS_PER_GROUP, HEAD_DIM)
    q, k, v = q.reshape(hs), k.reshape(hs), v.reshape(hs)
    u = gc * hc
    outs, lses = [], []
    if hist is None:
        for g, (_, d) in enumerate(ATTN_GROUPS):
            o, lse = dilated_band_attention(q[:, :, g], k[:, :, g], v[:, :, g], bias_g[g], d)
            outs.append(o)
            lses.append(lse)
        new_kv = [jnp.stack([k[:, -min(w, t):, g], v[:, -min(w, t):, g]], axis=2)
                  for g, (w, _) in enumerate(ATTN_GROUPS)]
        pm = pool_prompt(p)
        new_pool = p[:, -POOL_STATE:]
        u_ext = jnp.pad(u, ((0, 0), (CONV_K - 1, 0), (0, 0)))
    else:
        kv_caches, pool_state, conv_state, ffn_state = hist
        for g, (_, d) in enumerate(ATTN_GROUPS):
            cache = kv_caches[g]
            k_ext = jnp.concatenate([cache[:, :, 0], k[:, :, g]], axis=1)
            v_ext = jnp.concatenate([cache[:, :, 1], v[:, :, g]], axis=1)
            o, lse = dilated_cache_attention(q[:, :, g], k_ext, v_ext, bias_g[g], d, cache.shape[1])
            outs.append(o)
            lses.append(lse)
        new_kv = [jnp.stack([k[:, :, g], v[:, :, g]], axis=2) for g in range(N_ATTN_GROUPS)]
        pm, new_pool = pool_step(pool_state, p)
        u_ext = jnp.concatenate([conv_state, u], axis=1)
    br_c = combine_groups(outs, lses).reshape(nb, t, ATTN_OUT) @ w_attn_br
    pg = pm.astype(x.dtype).reshape(nb, t, len(POOL_WINDOWS), POOL_GROUP)
    pz = jnp.einsum('btgc,gce->btge', pg, w_pool_grp).reshape(nb, t, POOL_WIDTH)
    br_a = (pz * pool_scale) @ w_pool_br
    br_b = (gb * causal_dwconv(u_ext, conv_w)) @ w_conv_br
    new_conv = u_ext[:, -(CONV_K - 1):]
    gates = jax.nn.sigmoid(gl.reshape(nb, t, N_BRANCH, D_MODEL))
    merged = gates[:, :, 0] * br_a + gates[:, :, 1] * br_b + gates[:, :, 2] * br_c
    x = x + mod[:, 2] * rms_norm(merged @ w_o, norm_g[1])
    h2 = rms_norm(x, norm_g[2]) * (1 + mod[:, 4]) + mod[:, 3]
    up = h2 @ w_up
    if hist is None:
        up_ext = jnp.pad(up, ((0, 0), (FFN_CONV_K - 1, 0), (0, 0)))
    else:
        up_ext = jnp.concatenate([hist[3], up], axis=1)
    uc = causal_dwconv(up_ext, ffn_conv_w)
    f = (jax.nn.gelu(uc[..., :D_FF], approximate=True) * uc[..., D_FF:]) @ w_down
    new_ffn = up_ext[:, -(FFN_CONV_K - 1):]
    x = x + mod[:, 5] * rms_norm(f, norm_g[3])
    return x, (new_kv[0], new_kv[1], new_kv[2], new_pool, new_conv, new_ffn)


def setup_inputs(seed: int = 0) -> dict:
    key = jax.random.key(seed)
    ks = jax.random.split(key, 24)
    f32 = jnp.float32
    nrm = lambda k, shape, scale: jax.random.normal(k, shape, f32) * scale
    lc = [min(w, PAST_LEN) for w, _ in ATTN_GROUPS]
    return {
        'x_prompt': nrm(ks[0], (BATCH, SEQ, D_MODEL), 1.0),
        'x_sample': nrm(ks[1], (DEC_BATCH, DEC_SEQ, D_MODEL), 1.0),
        'c_prompt': nrm(ks[2], (BATCH, D_MODEL), 1.0),
        'c_sample': nrm(ks[3], (DEC_BATCH, D_MODEL), 1.0),
        'cache_kv_w128': nrm(ks[4], (DEPTH, DEC_BATCH, lc[0], 2, HEADS_PER_GROUP, HEAD_DIM), 1.0),
        'cache_kv_w512': nrm(ks[5], (DEPTH, DEC_BATCH, lc[1], 2, HEADS_PER_GROUP, HEAD_DIM), 1.0),
        'cache_kv_w2048': nrm(ks[6], (DEPTH, DEC_BATCH, lc[2], 2, HEADS_PER_GROUP, HEAD_DIM), 1.0),
        'state_pool': nrm(ks[7], (DEPTH, DEC_BATCH, POOL_STATE, POOL_WIDTH), 1.0),
        'state_conv': nrm(ks[8], (DEPTH, DEC_BATCH, CONV_K - 1, CONV_CH), 1.0),
        'state_ffn_conv': nrm(ks[9], (DEPTH, DEC_BATCH, FFN_CONV_K - 1, 2 * D_FF), 1.0),
        'rel_bias': nrm(ks[10], (N_BUCKETS, N_HEADS), 0.5),
        'norm_g': 1.0 + nrm(ks[11], (DEPTH, 4, D_MODEL), 0.02),
        'w_ada': nrm(ks[12], (DEPTH, D_MODEL, N_MOD * D_MODEL), 0.5 * D_MODEL ** -0.5),
        'b_ada': nrm(ks[13], (DEPTH, N_MOD * D_MODEL), 0.01),
        'w_in': nrm(ks[14], (DEPTH, D_MODEL, N_IN), D_MODEL ** -0.5),
        'w_attn_br': nrm(ks[15], (DEPTH, ATTN_OUT, D_MODEL), ATTN_OUT ** -0.5),
        'w_pool_grp': nrm(ks[16], (DEPTH, len(POOL_WINDOWS), POOL_GROUP, POOL_GROUP), POOL_GROUP ** -0.5),
        'pool_scale': 1.0 + nrm(ks[17], (DEPTH, POOL_WIDTH), 0.1),
        'w_pool_br': nrm(ks[18], (DEPTH, POOL_WIDTH, D_MODEL), POOL_WIDTH ** -0.5),
        'conv_w': nrm(ks[19], (DEPTH, CONV_K, CONV_CH), CONV_K ** -0.5),
        'w_conv_br': nrm(ks[20], (DEPTH, CONV_CH, D_MODEL), CONV_CH ** -0.5),
        'w_o': nrm(ks[21], (DEPTH, D_MODEL, D_MODEL), D_MODEL ** -0.5),
        'w_up': nrm(ks[22], (DEPTH, D_MODEL, 2 * D_FF), D_MODEL ** -0.5),
        'ffn_conv_w': nrm(jax.random.fold_in(ks[23], 1), (DEPTH, FFN_CONV_K, 2 * D_FF), FFN_CONV_K ** -0.5),
        'w_down': nrm(jax.random.fold_in(ks[23], 2), (DEPTH, D_FF, D_MODEL), D_FF ** -0.5),
    }


def reference(x_prompt, x_sample, c_prompt, c_sample, cache_kv_w128, cache_kv_w512, cache_kv_w2048,
              state_pool, state_conv, state_ffn_conv, rel_bias, norm_g, w_ada, b_ada, w_in, w_attn_br,
              w_pool_grp, pool_scale, w_pool_br, conv_w, w_conv_br, w_o, w_up, ffn_conv_w, w_down):
    bias_g = group_rel_bias(rel_bias)
    yp, ys = x_prompt, x_sample
    st_p, st_s = [], []
    for l in range(DEPTH):
        lw = (norm_g[l], w_ada[l], b_ada[l], w_in[l], w_attn_br[l], w_pool_grp[l], pool_scale[l],
              w_pool_br[l], conv_w[l], w_conv_br[l], w_o[l], w_up[l], ffn_conv_w[l], w_down[l])
        yp, sp = run_layer(yp, c_prompt, lw, bias_g, None)
        hist = ((cache_kv_w128[l], cache_kv_w512[l], cache_kv_w2048[l]), state_pool[l], state_conv[l], state_ffn_conv[l])
        ys, ss = run_layer(ys, c_sample, lw, bias_g, hist)
        st_p.append(sp)
        st_s.append(ss)
    kv128_p, kv512_p, kv2048_p, pool_p, conv_p, ffn_p = [jnp.stack([s[i] for s in st_p]) for i in range(6)]
    kv128_s, kv512_s, kv2048_s, pool_s, conv_s, ffn_s = [jnp.stack([s[i] for s in st_s]) for i in range(6)]
    return (yp, ys, kv128_p, kv512_p, kv2048_p, pool_p, conv_p, ffn_p,
            kv128_s, kv512_s, kv2048_s, pool_s, conv_s, ffn_s)
```

```cpp
#include <hip/hip_runtime.h>
#include <cstdint>
#include <cstdio>
#include <cmath>

#ifndef PROBE_RP
#define PROBE_RP 0
#define PROBE_RC 0
#endif
#ifndef MK_PER_PHASE
#define MK_PER_PHASE 0
#endif

#define LAS __attribute__((address_space(3)))
#define GAS __attribute__((address_space(1)))

namespace pg8 {
typedef unsigned short bf16_t;
typedef short bf16x8 __attribute__((ext_vector_type(8)));
typedef float f32x4 __attribute__((ext_vector_type(4)));
typedef unsigned u32x4 __attribute__((ext_vector_type(4)));
typedef unsigned u32x2 __attribute__((ext_vector_type(2)));
constexpr int BM = 256, BK = 64, HALF = 128, HTB = HALF * BK * 2, STAGE_BYTES = 8 * HTB, NXCD = 8, WGM = 8;

__host__ __device__ __forceinline__ int lds_byte(int r, int c) { const int st = (r >> 4) * 2 + (c >> 5), rr = r & 15, cc = c & 31, ob = rr * 64 + cc * 2; return st * 1024 + (ob ^ (((ob >> 9) & 1) << 5)); }
__host__ __device__ __forceinline__ void stage_rc(int b, int& R, int& C) { const int st = b / 1024, sb = b % 1024, swz = sb ^ (((sb >> 9) & 1) << 5); R = (st >> 1) * 16 + swz / 64; C = (st & 1) * 32 + (swz % 64) / 2; }
__host__ __device__ __forceinline__ int perm32(int rho) { const int n = rho >> 4, i = rho & 15; return 8 * (i >> 2) + 4 * n + (i & 3); }

struct Unit { int pm, pn, seg, nt; const char* a; const char* b; };
struct Gemm { const bf16_t* A; const bf16_t* Bt; int M, N, K, lda, ldb; };

__device__ __forceinline__ void tile_of(int wgid, int nM, int nN, int& pm, int& pn) {
    const int nwg = nM * nN; { const int q = nwg / NXCD, r = nwg % NXCD, xcd = wgid % NXCD, off = wgid / NXCD; wgid = (xcd < r ? xcd * (q + 1) : r * (q + 1) + (xcd - r) * q) + off; }
    const int nig = WGM * nN, gid = wgid / nig, fm = gid * WGM, gsz = (nM - fm) < WGM ? (nM - fm) : WGM;
    pm = fm + ((wgid % nig) % gsz); pn = (wgid % nig) / gsz;
}
struct StaticOrder {
    int nM, nN, nwg, G, c, nt; const char* A; const char* B; size_t tA, tB;
    __device__ void init(const Gemm& g, int G_, int c_) { nM = g.M / BM; nN = g.N / BM; nwg = nM * nN; G = G_; c = c_; nt = g.K / BK; A = (const char*)g.A; B = (const char*)g.Bt; tA = (size_t)BM * g.lda * 2; tB = (size_t)BM * g.ldb * 2; }
    __device__ bool next(int i, Unit& u) const {
        const long L = (long)i * G + c; if (L >= nwg) return false;
        tile_of((int)L, nM, nN, u.pm, u.pn); u.seg = 0; u.nt = nt; u.a = A + (size_t)u.pm * tA; u.b = B + (size_t)u.pn * tB; return true;
    }
};
struct SegOrder {
    int pm, pn; const char* A; const char* B; size_t tA, tB;
    __device__ void init(const Gemm& g, int c_) { tile_of(c_, g.M / BM, g.N / BM, pm, pn); A = (const char*)g.A; B = (const char*)g.Bt; tA = (size_t)BM * g.lda * 2; tB = (size_t)BM * g.ldb * 2; }
    __device__ bool next(int i, Unit& u) const {
        if (i >= 3) return false;
        u.pm = pm; u.pn = pn; u.seg = i; u.nt = (i == 2) ? 4 : 8; u.a = A + (size_t)pm * tA + (size_t)i * 1024; u.b = B + (size_t)pn * tB + (size_t)i * 1024; return true;
    }
};

__device__ __forceinline__ unsigned cvt_pk_bf16(float lo, float hi) { unsigned r; asm volatile("v_cvt_pk_bf16_f32 %0, %1, %2" : "=v"(r) : "v"(lo), "v"(hi)); return r; }
__device__ __forceinline__ float bf_lo(unsigned w) { return __uint_as_float(w << 16); }
__device__ __forceinline__ float bf_hi(unsigned w) { return __uint_as_float(w & 0xffff0000u); }

__device__ __forceinline__ void store16_wt(void* p, u32x4 v) { asm volatile("global_store_dwordx4 %0, %1, off sc1\n\ts_nop 1" :: "v"(p), "v"(v) : "memory"); }
struct EpiBf16 {
    static constexpr bool PERM = true, KEEP_ACC = false;
    bf16_t* O; int ldc;
    __device__ __forceinline__ void operator()(const f32x4 (&acc)[2][2][4][2], const Unit& u, int wr, int wc, int fr, int fq) const {
        const int row0 = u.pm * BM + wr * 64 + fr, col0 = u.pn * BM + wc * 32 + 8 * fq;
#pragma unroll
        for (int ai = 0; ai < 2; ++ai)
#pragma unroll
            for (int m = 0; m < 4; ++m) { bf16_t* rowp = O + (size_t)(row0 + ai * HALF + m * 16) * ldc + col0;
#pragma unroll
                for (int bj = 0; bj < 2; ++bj) { const f32x4 v0 = acc[ai][bj][m][0], v1 = acc[ai][bj][m][1];
                    u32x4 w; w.x = cvt_pk_bf16(v0[0], v0[1]); w.y = cvt_pk_bf16(v0[2], v0[3]); w.z = cvt_pk_bf16(v1[0], v1[1]); w.w = cvt_pk_bf16(v1[2], v1[3]);
                    store16_wt(rowp + bj * HALF, w); } }
    }
};
struct EpiF32 {
    static constexpr bool PERM = false, KEEP_ACC = false;
    float* C; int ldc;
    __device__ __forceinline__ void operator()(const f32x4 (&acc)[2][2][4][2], const Unit& u, int wr, int wc, int fr, int fq) const {
        const int row0 = u.pm * BM + wr * 64 + fr, col0 = u.pn * BM + wc * 32 + 4 * fq;
#pragma unroll
        for (int ai = 0; ai < 2; ++ai)
#pragma unroll
            for (int m = 0; m < 4; ++m) { float* rowp = C + (size_t)(row0 + ai * HALF + m * 16) * ldc + col0;
#pragma unroll
                for (int bj = 0; bj < 2; ++bj)
#pragma unroll
                    for (int n = 0; n < 2; ++n) *(f32x4*)(rowp + bj * HALF + n * 16) = acc[ai][bj][m][n]; }
    }
};
struct EpiGate {
    static constexpr bool PERM = true, KEEP_ACC = true;
    const bf16_t* gl0; int ldg; bf16_t* MG;
    __device__ __forceinline__ void operator()(f32x4 (&acc)[2][2][4][2], const Unit& u, int wr, int wc, int fr, int fq) const {
        const int row0 = u.pm * BM + wr * 64 + fr, col0 = u.pn * BM + wc * 32 + 8 * fq, seg = u.seg;
        const bf16_t* gn = gl0 + 2048 * seg;
        const bf16_t* gd = gl0 + 2048 * (seg < 2 ? seg + 1 : seg);
#pragma unroll
        for (int ai = 0; ai < 2; ++ai) {
            u32x4 gw[4][2], hw[4][2];
#pragma unroll
            for (int m = 0; m < 4; ++m)
#pragma unroll
                for (int bj = 0; bj < 2; ++bj) { const size_t o = (size_t)(row0 + ai * HALF + m * 16) * ldg + col0 + bj * HALF;
                    gw[m][bj] = *(const u32x4*)(gn + o); hw[m][bj] = *(const u32x4*)(gd + o); }
#pragma unroll
            for (int m = 0; m < 4; ++m)
#pragma unroll
                for (int bj = 0; bj < 2; ++bj) { const int r = row0 + ai * HALF + m * 16, c = col0 + bj * HALF;
                    const u32x4 g4 = gw[m][bj], h4 = hw[m][bj];
                    float g[8], h[8];
                    g[0] = bf_lo(g4.x); g[1] = bf_hi(g4.x); g[2] = bf_lo(g4.y); g[3] = bf_hi(g4.y); g[4] = bf_lo(g4.z); g[5] = bf_hi(g4.z); g[6] = bf_lo(g4.w); g[7] = bf_hi(g4.w);
                    h[0] = bf_lo(h4.x); h[1] = bf_hi(h4.x); h[2] = bf_lo(h4.y); h[3] = bf_hi(h4.y); h[4] = bf_lo(h4.z); h[5] = bf_hi(h4.z); h[6] = bf_lo(h4.w); h[7] = bf_hi(h4.w);
                    float v[8];
#pragma unroll
                    for (int j = 0; j < 8; ++j) { const float num = (seg < 2) ? (1.0f + __expf(-h[j])) : 1.0f;
                        v[j] = acc[ai][bj][m][j >> 2][j & 3] * num * __builtin_amdgcn_rcpf(1.0f + __expf(-g[j])); acc[ai][bj][m][j >> 2][j & 3] = v[j]; }
                    if (seg == 2) { u32x4 w; w.x = cvt_pk_bf16(v[0], v[1]); w.y = cvt_pk_bf16(v[2], v[3]); w.z = cvt_pk_bf16(v[4], v[5]); w.w = cvt_pk_bf16(v[6], v[7]);
                        *(u32x4*)(MG + (size_t)r * 2048 + c) = w; } }
        }
    }
};

template <class Epi, bool ALIGN_EPI, class Sched>
__device__ __forceinline__ void gemm_phase(LAS unsigned char* lds, const int tid, const Gemm g, const Sched& S, const Epi& E) {
    const int wid = __builtin_amdgcn_readfirstlane(tid >> 6), lane = tid & 63, wr = wid >> 2, wc = wid & 3, fr = lane & 15, fq = lane >> 4;
    unsigned voffA[2], voffB[2];
#pragma unroll
    for (int i = 0; i < 2; ++i) { int R, C; stage_rc(tid * 16 + i * 8192, R, C); const int Rb = Epi::PERM ? ((R & ~31) + perm32(R & 31)) : R;
        voffA[i] = (unsigned)(R * g.lda + C) * 2u; voffB[i] = (unsigned)(Rb * g.ldb + C) * 2u; }
    const size_t kstep = (size_t)(BK * 2);
    const size_t hstepA = (size_t)HALF * g.lda * 2, hstepB = (size_t)HALF * g.ldb * 2;
    const unsigned ldsw = (unsigned)wid * 1024u;
    const int aoff = lds_byte(wr * 64 + fr, fq * 8), boff = lds_byte(wc * 32 + fr, fq * 8);
#define PG8_SA(b, h) (((b) * 2 + (h)) * HTB)
#define PG8_SB(b, h) ((4 + (b) * 2 + (h)) * HTB)
#define PG8_STAGE(bufoff, gbase, voff) do { _Pragma("unroll") for (int _i = 0; _i < 2; ++_i) \
        __builtin_amdgcn_global_load_lds((const unsigned*)((const char*)(gbase) + (voff)[_i]), (LAS unsigned*)(lds + (bufoff) + ldsw + _i * 8192), 16, 0, 0); } while (0)
#define PG8_LDA(dst, b, h) do { _Pragma("unroll") for (int m = 0; m < 4; ++m) _Pragma("unroll") for (int k = 0; k < 2; ++k) dst[m][k] = *(const LAS bf16x8*)(lds + PG8_SA(b, h) + aoff + m * 2048 + k * 1024); } while (0)
#define PG8_LDB(dst, b, h) do { _Pragma("unroll") for (int n = 0; n < 2; ++n) _Pragma("unroll") for (int k = 0; k < 2; ++k) dst[n][k] = *(const LAS bf16x8*)(lds + PG8_SB(b, h) + boff + n * 2048 + k * 1024); } while (0)
#define PG8_MMA(ai, bj, At, Bt) do { __builtin_amdgcn_s_setprio(1); _Pragma("unroll") for (int m = 0; m < 4; ++m) _Pragma("unroll") for (int n = 0; n < 2; ++n) _Pragma("unroll") for (int k = 0; k < 2; ++k) \
        acc[ai][bj][m][n] = __builtin_amdgcn_mfma_f32_16x16x32_bf16(Bt[n][k], At[m][k], acc[ai][bj][m][n], 0, 0, 0); __builtin_amdgcn_s_setprio(0); } while (0)
#define PG8_WAIT_V(n) asm volatile("s_waitcnt vmcnt(" #n ")" ::: "memory")
#define PG8_WAIT_L(n) asm volatile("s_waitcnt lgkmcnt(" #n ")" ::: "memory")
#define PG8_BAR __builtin_amdgcn_s_barrier()
#define PG8_SCHED __builtin_amdgcn_sched_barrier(0)
    Unit cur, nxt; int ui = 0;
    if (!S.next(0, cur)) return;
    f32x4 acc[2][2][4][2];
#pragma unroll
    for (int a = 0; a < 2; ++a)
#pragma unroll
        for (int b = 0; b < 2; ++b)
#pragma unroll
            for (int m = 0; m < 4; ++m)
#pragma unroll
                for (int n = 0; n < 2; ++n) acc[a][b][m][n] = (f32x4){0.f, 0.f, 0.f, 0.f};
    bf16x8 At[4][2], B0[2][2], B1[2][2];
    const char* cA = cur.a; const char* cB = cur.b;
    PG8_STAGE(PG8_SB(0, 0), cB, voffB); PG8_STAGE(PG8_SB(0, 1), cB + hstepB, voffB); PG8_STAGE(PG8_SA(0, 0), cA, voffA); PG8_STAGE(PG8_SA(0, 1), cA + hstepA, voffA);
    if (wr == 1) PG8_BAR;
    PG8_WAIT_V(2); PG8_BAR;
    PG8_STAGE(PG8_SB(1, 0), cB + kstep, voffB); PG8_STAGE(PG8_SA(1, 0), cA + kstep, voffA); PG8_STAGE(PG8_SB(1, 1), cB + hstepB + kstep, voffB);
    PG8_WAIT_V(6); PG8_BAR;
    for (;;) {
        const bool has_next = S.next(ui + 1, nxt);
        const char* nA = has_next ? nxt.a : cA; const char* nB = has_next ? nxt.b : cB;
        const int nt = cur.nt;
        for (int t = 0; t < nt; t += 2) {
            const bool last = (t == nt - 2);
            const char* a1 = cA + (size_t)(t + 1) * kstep;
            const char* a2 = last ? nA : cA + (size_t)(t + 2) * kstep; const char* b2 = last ? nB : cB + (size_t)(t + 2) * kstep;
            const char* a3 = a2 + kstep; const char* b3 = b2 + kstep;
            PG8_LDB(B0, 0, 0); PG8_LDB(B1, 0, 1); PG8_SCHED; PG8_LDA(At, 0, 0); PG8_STAGE(PG8_SA(1, 1), a1 + hstepA, voffA);
            PG8_WAIT_V(8); PG8_WAIT_L(0); PG8_BAR; PG8_MMA(0, 0, At, B0); PG8_MMA(0, 1, At, B1); PG8_BAR; PG8_SCHED;
            PG8_LDA(At, 0, 1); PG8_STAGE(PG8_SB(0, 0), b2, voffB); PG8_STAGE(PG8_SB(0, 1), b2 + hstepB, voffB); PG8_STAGE(PG8_SA(0, 0), a2, voffA);
            PG8_WAIT_V(8); PG8_WAIT_L(0); PG8_BAR; PG8_MMA(1, 0, At, B0); PG8_MMA(1, 1, At, B1); PG8_BAR; PG8_SCHED;
            PG8_LDB(B0, 1, 0); PG8_LDB(B1, 1, 1); PG8_SCHED; PG8_LDA(At, 1, 0); PG8_STAGE(PG8_SA(0, 1), a2 + hstepA, voffA);
            PG8_WAIT_V(8); PG8_WAIT_L(0); PG8_BAR; PG8_MMA(0, 0, At, B0); PG8_MMA(0, 1, At, B1); PG8_BAR; PG8_SCHED;
            PG8_LDA(At, 1, 1); PG8_STAGE(PG8_SB(1, 0), b3, voffB); PG8_STAGE(PG8_SB(1, 1), b3 + hstepB, voffB); PG8_STAGE(PG8_SA(1, 0), a3, voffA);
            PG8_WAIT_V(8); PG8_WAIT_L(0); PG8_BAR; PG8_MMA(1, 0, At, B0); PG8_MMA(1, 1, At, B1); PG8_BAR; PG8_SCHED;
        }
        if constexpr (ALIGN_EPI) { if (wr == 0) PG8_BAR; }
        E(acc, cur, wr, wc, fr, fq);
        if (!has_next) break;
        if constexpr (!Epi::KEEP_ACC) {
#pragma unroll
        for (int a = 0; a < 2; ++a)
#pragma unroll
            for (int b = 0; b < 2; ++b)
#pragma unroll
                for (int m = 0; m < 4; ++m)
#pragma unroll
                    for (int n = 0; n < 2; ++n) acc[a][b][m][n] = (f32x4){0.f, 0.f, 0.f, 0.f};
        }
        cur = nxt; cA = nA; cB = nB; ++ui;
        if constexpr (ALIGN_EPI) { if (wr == 1) PG8_BAR; }
    }
    PG8_WAIT_V(0);
    if constexpr (!ALIGN_EPI) { if (wr == 0) PG8_BAR; }
    PG8_BAR;
#undef PG8_SA
#undef PG8_SB
#undef PG8_STAGE
#undef PG8_LDA
#undef PG8_LDB
#undef PG8_MMA
#undef PG8_WAIT_V
#undef PG8_WAIT_L
#undef PG8_BAR
#undef PG8_SCHED
}
}

typedef unsigned short bf16;
typedef unsigned v4u __attribute__((ext_vector_type(4)));
typedef unsigned v2u __attribute__((ext_vector_type(2)));
typedef float f32x4 __attribute__((ext_vector_type(4)));

constexpr int D_MODEL = 2048, BATCH = 2, SEQ = 4096, DEPTH = 2, DEC_BATCH = 8;
constexpr int MP = BATCH * SEQ, MT = MP + DEC_BATCH, NB = BATCH + DEC_BATCH;
constexpr int N_IN = 10496, D_FF = 5632, N_UP = 2 * D_FF, N_MOD = 6, K_BR = 1280;
constexpr int OFF_Q = 0, OFF_K = 768, OFF_V = 1536, OFF_P = 2304, OFF_GB = 2816, OFF_GC = 3328, OFF_HC = 3840, OFF_GL = 4352;
constexpr float EPS = 1e-6f;
constexpr int NWAVES = 8, NTHREADS = 512;
constexpr int LDS_BYTES = 147456;

constexpr size_t al256(size_t x) { return (x + 255) & ~(size_t)255; }
constexpr size_t WS_CTL = 0, CTL_BYTES = 1u << 20;
constexpr size_t SZ_WTIN = (size_t)N_IN * D_MODEL * 2, SZ_WTBR = (size_t)D_MODEL * K_BR * 2, SZ_WTO = (size_t)D_MODEL * D_MODEL * 2, SZ_WTUP = (size_t)N_UP * D_MODEL * 2, SZ_WTDN = (size_t)D_MODEL * D_FF * 2;
constexpr size_t WS_WTIN = WS_CTL + CTL_BYTES;
constexpr size_t WS_WTBR = WS_WTIN + DEPTH * SZ_WTIN;
constexpr size_t WS_WTO = WS_WTBR + DEPTH * SZ_WTBR;
constexpr size_t WS_WTUP = WS_WTO + DEPTH * SZ_WTO;
constexpr size_t WS_WTDN = WS_WTUP + DEPTH * SZ_WTUP;
constexpr size_t WS_MOD = WS_WTDN + DEPTH * SZ_WTDN;
constexpr size_t WS_BIAS = WS_MOD + al256((size_t)DEPTH * NB * N_MOD * D_MODEL * 4);
constexpr size_t WS_H = WS_BIAS + 8192;
constexpr size_t WS_Y = WS_H + al256((size_t)MT * D_MODEL * 2);
constexpr size_t WS_A2 = WS_Y + al256((size_t)MT * N_UP * 2);
constexpr size_t WS_T = WS_A2 + al256((size_t)MT * K_BR * 2);
constexpr size_t WS_MG = WS_T + al256((size_t)MT * D_MODEL * 4);
constexpr size_t WS_ACT = WS_MG + al256((size_t)MT * D_MODEL * 2);
constexpr size_t WS_XS = WS_ACT + al256((size_t)MT * D_FF * 2);
constexpr size_t WS_OG = WS_XS + al256((size_t)DEC_BATCH * D_MODEL * 4);
constexpr size_t WS_LSE = WS_OG + al256((size_t)MT * 768 * 2);
constexpr size_t WS_XB = WS_LSE + al256((size_t)MT * 12 * 4);
constexpr size_t WS_PM = WS_XB + al256((size_t)MP * D_MODEL * 2);
constexpr size_t WS_END = WS_PM + al256((size_t)8 * DEPTH * NB * N_MOD * D_MODEL * 4);

struct BucketTab { unsigned char b[3][132]; unsigned pad; };
struct Params {
    const float *x_prompt, *x_sample, *c_prompt, *c_sample, *c128, *c512, *c2048, *state_pool, *state_conv, *state_ffn, *rel_bias, *norm_g, *w_ada, *b_ada, *w_in,
        *w_attn_br, *w_pool_grp, *pool_scale, *w_pool_br, *conv_w, *w_conv_br, *w_o, *w_up, *ffn_conv_w, *w_down;
    float* out; unsigned char* ws;
    BucketTab tab;
    int ph_lo, ph_hi, rp, rc;
};

constexpr int PARAM_LDS_OFF = 131072 + 1024;
struct PL {
    LAS const unsigned char* b;
    __device__ __forceinline__ const float* ldp(int off) const { const LAS unsigned* q = (const LAS unsigned*)(b + off);
        const unsigned lo = __builtin_amdgcn_readfirstlane(q[0]), hi = __builtin_amdgcn_readfirstlane(q[1]); return (const float*)(const GAS float*)(((unsigned long long)hi << 32) | lo); }
#define PL_F(name) __device__ __forceinline__ const float* name() const { return ldp((int)offsetof(Params, name)); }
    PL_F(x_prompt)
    PL_F(x_sample)
    PL_F(c_prompt)
    PL_F(c_sample)
    PL_F(c128)
    PL_F(c512)
    PL_F(c2048)
    PL_F(state_pool)
    PL_F(state_conv)
    PL_F(state_ffn)
    PL_F(rel_bias)
    PL_F(norm_g)
    PL_F(w_ada)
    PL_F(b_ada)
    PL_F(w_in)
    PL_F(w_attn_br)
    PL_F(w_pool_grp)
    PL_F(pool_scale)
    PL_F(w_pool_br)
    PL_F(conv_w)
    PL_F(w_conv_br)
    PL_F(w_o)
    PL_F(w_up)
    PL_F(ffn_conv_w)
    PL_F(w_down)
#undef PL_F
    __device__ __forceinline__ int bucket(int g, int n) const { return (int)b[(int)offsetof(Params, tab) + g * 132 + n]; }
};
constexpr size_t O_YP = 0, O_YS = O_YP + (size_t)MP * D_MODEL;
constexpr size_t O_KVP0 = O_YS + (size_t)DEC_BATCH * D_MODEL;
constexpr size_t O_KVP1 = O_KVP0 + (size_t)DEPTH * BATCH * 128 * 512;
constexpr size_t O_KVP2 = O_KVP1 + (size_t)DEPTH * BATCH * 512 * 512;
constexpr size_t O_POOLP = O_KVP2 + (size_t)DEPTH * BATCH * 2048 * 512;
constexpr size_t O_CONVP = O_POOLP + (size_t)DEPTH * BATCH * 15 * 512;
constexpr size_t O_FFNP = O_CONVP + (size_t)DEPTH * BATCH * 2 * 512;
constexpr size_t O_KVS0 = O_FFNP + (size_t)DEPTH * BATCH * 2 * N_UP;
constexpr size_t O_KVS1 = O_KVS0 + (size_t)DEPTH * DEC_BATCH * 512;
constexpr size_t O_KVS2 = O_KVS1 + (size_t)DEPTH * DEC_BATCH * 512;
constexpr size_t O_POOLS = O_KVS2 + (size_t)DEPTH * DEC_BATCH * 512;
constexpr size_t O_CONVS = O_POOLS + (size_t)DEPTH * DEC_BATCH * 15 * 512;
constexpr size_t O_FFNS = O_CONVS + (size_t)DEPTH * DEC_BATCH * 2 * 512;
constexpr size_t O_END = O_FFNS + (size_t)DEPTH * DEC_BATCH * 2 * N_UP;

__device__ __forceinline__ float bf2f(bf16 v) { return __uint_as_float((unsigned)v << 16); }
__device__ __forceinline__ unsigned f2bf(float f) { unsigned u = __float_as_uint(f); return (u + 0x7fffu + ((u >> 16) & 1u)) >> 16; }
__device__ __forceinline__ unsigned pk2(float lo, float hi) { return pg8::cvt_pk_bf16(lo, hi); }
__device__ __forceinline__ float blo(unsigned w) { return __uint_as_float(w << 16); }
__device__ __forceinline__ float bhi(unsigned w) { return __uint_as_float(w & 0xffff0000u); }
__device__ __forceinline__ void unpack8(const v4u w, float (&f)[8]) { f[0] = blo(w.x); f[1] = bhi(w.x); f[2] = blo(w.y); f[3] = bhi(w.y); f[4] = blo(w.z); f[5] = bhi(w.z); f[6] = blo(w.w); f[7] = bhi(w.w); }
__device__ __forceinline__ v4u pack8(const float (&f)[8]) { v4u w; w.x = pk2(f[0], f[1]); w.y = pk2(f[2], f[3]); w.z = pk2(f[4], f[5]); w.w = pk2(f[6], f[7]); return w; }
typedef __bf16 bf16x2_t __attribute__((ext_vector_type(2)));
__device__ __forceinline__ float dot2bf(unsigned a, unsigned b, float acc) { return __builtin_amdgcn_fdot2_f32_bf16(__builtin_bit_cast(bf16x2_t, a), __builtin_bit_cast(bf16x2_t, b), acc, false); }
__device__ __forceinline__ float dot8(const v4u a, const v4u b, float acc) { acc = dot2bf(a.x, b.x, acc); acc = dot2bf(a.y, b.y, acc); acc = dot2bf(a.z, b.z, acc); return dot2bf(a.w, b.w, acc); }
__device__ __forceinline__ float wave_sum(float v) {
#pragma unroll
    for (int o = 1; o < 64; o <<= 1) v += __shfl_xor(v, o);
    return v; }
__device__ __forceinline__ float wave_max(float v) {
#pragma unroll
    for (int o = 1; o < 64; o <<= 1) v = fmaxf(v, __shfl_xor(v, o));
    return v; }
#define LDS_FENCE() asm volatile("s_waitcnt lgkmcnt(0)" ::: "memory")
__device__ __forceinline__ float reduce8(const float (&a)[8], int lane) {
    float b[4], c2[2], d;
    const bool h32 = (lane & 32) != 0, h16 = (lane & 16) != 0, h8 = (lane & 8) != 0;
#pragma unroll
    for (int i = 0; i < 4; ++i) { const float snd = h32 ? a[i] : a[i + 4], kep = h32 ? a[i + 4] : a[i]; b[i] = kep + __shfl_xor(snd, 32); }
#pragma unroll
    for (int i = 0; i < 2; ++i) { const float snd = h16 ? b[i] : b[i + 2], kep = h16 ? b[i + 2] : b[i]; c2[i] = kep + __shfl_xor(snd, 16); }
    { const float snd = h8 ? c2[0] : c2[1], kep = h8 ? c2[1] : c2[0]; d = kep + __shfl_xor(snd, 8); }
    d += __shfl_xor(d, 4); d += __shfl_xor(d, 2); d += __shfl_xor(d, 1);
    return d;
}
__device__ __forceinline__ float sigmoidf_(float x) { float e = __expf(-x); asm volatile("" : "+v"(e)); return __builtin_amdgcn_rcpf(1.0f + e); }
__device__ __forceinline__ float gelu_tanh(float x) {
    const float z = x * fmaf(-0.1029432396f, x * x, -2.3022081981f);
    return x * __builtin_amdgcn_rcpf(1.0f + __builtin_amdgcn_exp2f(z)); }

__device__ __forceinline__ int up_perm(int n) { return n < D_FF ? 256 * (n >> 7) + (n & 127) : 256 * ((n - D_FF) >> 7) + 128 + ((n - D_FF) & 127); }
__device__ __forceinline__ int up_unperm(int r) { return ((r >> 7) & 1) * D_FF + 128 * (r >> 8) + (r & 127); }
template <int N> __device__ __forceinline__ float dpp_ror(float x) { return __int_as_float(__builtin_amdgcn_mov_dpp(__float_as_int(x), 0x120 + N, 0xf, 0xf, false)); }
struct EpiFfn {
    static constexpr bool PERM = true, KEEP_ACC = false;
    bf16* ACT; bf16* UP; const float* fw;
    __device__ __forceinline__ void operator()(const f32x4 (&acc)[2][2][4][2], const pg8::Unit& u, int wr, int wc, int fr, int fq) const {
        const int row0 = u.pm * 256 + wr * 64 + fr, j0 = u.pn * 128 + wc * 32 + 8 * fq;
        v2u keep[2][4];
        f32x4 wga[2][3], wva[2][3];
#pragma unroll
        for (int n = 0; n < 2; ++n)
#pragma unroll
            for (int t = 0; t < 3; ++t) { wga[n][t] = *(const f32x4*)(fw + (size_t)t * N_UP + j0 + 4 * n); wva[n][t] = *(const f32x4*)(fw + (size_t)t * N_UP + D_FF + j0 + 4 * n); }
#pragma unroll
        for (int n = 0; n < 2; ++n) {
            const int j = j0 + 4 * n;
            f32x4 wg[3], wv[3];
#pragma unroll
            for (int t = 0; t < 3; ++t) { wg[t] = wga[n][t]; wv[t] = wva[n][t]; }
#pragma unroll
            for (int ai = 0; ai < 2; ++ai) {
                f32x4 g1p = (f32x4){0.f, 0.f, 0.f, 0.f}, g2p = g1p, v1p = g1p, v2p = g1p;
#pragma unroll
                for (int m = 0; m < 4; ++m) {
                    const f32x4 g = acc[ai][0][m][n], v = acc[ai][1][m][n];
                    f32x4 g1, g2, v1, v2, o;
#pragma unroll
                    for (int e = 0; e < 4; ++e) { g1[e] = dpp_ror<1>(g[e]); g2[e] = dpp_ror<2>(g[e]); v1[e] = dpp_ror<1>(v[e]); v2[e] = dpp_ror<2>(v[e]); }
                    {
                        const f32x4 pg1 = fr >= 1 ? g1 : g1p, pg2 = fr >= 2 ? g2 : g2p, pv1 = fr >= 1 ? v1 : v1p, pv2 = fr >= 2 ? v2 : v2p;
                        const f32x4 cg = wg[2] * g + wg[1] * pg1 + wg[0] * pg2, cv = wv[2] * v + wv[1] * pv1 + wv[0] * pv2;
                        const f32x4 z = cg * (cg * cg * (-0.1029432396f) + (-2.3022081981f));
                        f32x4 d;
#pragma unroll
                        for (int e = 0; e < 4; ++e) d[e] = __builtin_amdgcn_exp2f(z[e]);
                        d = d + 1.0f;
#pragma unroll
                        for (int e = 0; e < 4; ++e) d[e] = __builtin_amdgcn_rcpf(d[e]);
                        o = cg * d * cv; }
                    const int r = row0 + 128 * ai + 16 * m;
                    v2u pk; pk.x = pg8::cvt_pk_bf16(o[0], o[1]); pk.y = pg8::cvt_pk_bf16(o[2], o[3]);
                    if (n == 0) keep[ai][m] = pk;
                    else if (!(m == 0 && fr < 2)) { v4u w; w.x = keep[ai][m].x; w.y = keep[ai][m].y; w.z = pk.x; w.w = pk.y; *(v4u*)(ACT + (size_t)r * D_FF + j0) = w; }
                    if ((m == 0 && fr < 2) || (m == 3 && fr >= 14)) {
                        v2u rg, rv; rg.x = pg8::cvt_pk_bf16(g[0], g[1]); rg.y = pg8::cvt_pk_bf16(g[2], g[3]); rv.x = pg8::cvt_pk_bf16(v[0], v[1]); rv.y = pg8::cvt_pk_bf16(v[2], v[3]);
                        *(v2u*)(UP + (size_t)r * N_UP + j) = rg; *(v2u*)(UP + (size_t)r * N_UP + D_FF + j) = rv; }
                    g1p = g1; g2p = g2; v1p = v1; v2p = v2;
                }
            }
        }
    }
};
struct StBf16Up { bf16* O; __device__ __forceinline__ void operator()(int n, int r, float v) const { O[(size_t)r * N_UP + up_unperm(n)] = (bf16)f2bf(v); } };

struct Ctx {
    LAS unsigned char* lds; int tid, lane, wave, gw, NGW, bid, G;
};
struct StBf16 { bf16* O; int ld; __device__ __forceinline__ void operator()(int n, int r, float v) const { O[(size_t)r * ld + n] = (bf16)f2bf(v); } };
struct StF32 { float* O; int ld; __device__ __forceinline__ void operator()(int n, int r, float v) const { O[(size_t)r * ld + n] = v; } };

struct TItem { const float* src; bf16* dst; int N, ldt; };
__device__ __forceinline__ TItem titem_desc(const PL p, unsigned char* ws, int it) {
    constexpr int I_IN = (D_MODEL / 64) * (N_IN / 32), I_O = (D_MODEL / 64) * (D_MODEL / 32), I_UP = (D_MODEL / 64) * (N_UP / 32), I_DN = (D_FF / 64) * (D_MODEL / 32),
                  I_CV = (512 / 64) * (D_MODEL / 32), I_AT = (256 / 64) * (D_MODEL / 32), I_L = I_IN + I_O + I_UP + I_DN + I_CV + I_AT;
    const int l = it / I_L; int r = it % I_L;
    const float* W; bf16* WT; int N, ldt, koff = 0, k0, n0;
    if (r < I_IN) { W = p.w_in() + (size_t)l * D_MODEL * N_IN; N = N_IN; WT = (bf16*)(ws + WS_WTIN + l * SZ_WTIN); ldt = D_MODEL; k0 = 64 * (r / (N_IN / 32)); n0 = 32 * (r % (N_IN / 32)); }
    else if ((r -= I_IN) < I_O) { W = p.w_o() + (size_t)l * D_MODEL * D_MODEL; N = D_MODEL; WT = (bf16*)(ws + WS_WTO + l * SZ_WTO); ldt = D_MODEL; k0 = 64 * (r / (D_MODEL / 32)); n0 = 32 * (r % (D_MODEL / 32)); }
    else if ((r -= I_O) < I_UP) { W = p.w_up() + (size_t)l * D_MODEL * N_UP; N = N_UP; WT = (bf16*)(ws + WS_WTUP + l * SZ_WTUP); ldt = D_MODEL; k0 = 64 * (r / (N_UP / 32)); n0 = 32 * (r % (N_UP / 32)); }
    else if ((r -= I_UP) < I_DN) { W = p.w_down() + (size_t)l * D_FF * D_MODEL; N = D_MODEL; WT = (bf16*)(ws + WS_WTDN + l * SZ_WTDN); ldt = D_FF; k0 = 64 * (r / (D_MODEL / 32)); n0 = 32 * (r % (D_MODEL / 32)); }
    else if ((r -= I_DN) < I_CV) { W = p.w_conv_br() + (size_t)l * 512 * D_MODEL; N = D_MODEL; WT = (bf16*)(ws + WS_WTBR + l * SZ_WTBR); ldt = K_BR; koff = 512; k0 = 64 * (r / (D_MODEL / 32)); n0 = 32 * (r % (D_MODEL / 32)); }
    else { r -= I_CV; W = p.w_attn_br() + (size_t)l * 256 * D_MODEL; N = D_MODEL; WT = (bf16*)(ws + WS_WTBR + l * SZ_WTBR); ldt = K_BR; koff = 1024; k0 = 64 * (r / (D_MODEL / 32)); n0 = 32 * (r % (D_MODEL / 32)); }
    const int nrow = (N == N_UP) ? up_perm(n0) : n0;
    TItem t; t.src = W + (size_t)k0 * N + n0; t.dst = WT + (size_t)nrow * ldt + koff + k0; t.N = N; t.ldt = ldt; return t;
}
constexpr int N_TITEMS = DEPTH * ((D_MODEL / 64) * (N_IN / 32) + (D_MODEL / 64) * (D_MODEL / 32) + (D_MODEL / 64) * (N_UP / 32) + (D_FF / 64) * (D_MODEL / 32) + (512 / 64) * (D_MODEL / 32) + (256 / 64) * (D_MODEL / 32));
__device__ __forceinline__ void titem_load(const TItem& t, int lane, f32x4 (&v)[8]) {
    const float* s = t.src + (size_t)(8 * (lane >> 3)) * t.N + 4 * (lane & 7);
#pragma unroll
    for (int j = 0; j < 8; ++j) v[j] = __builtin_nontemporal_load((const f32x4*)(s + (size_t)j * t.N));
}
__device__ __forceinline__ void titem_store(const TItem& t, int lane, const f32x4 (&v)[8]) {
    bf16* d = t.dst + (size_t)(4 * (lane & 7)) * t.ldt + 8 * (lane >> 3);
#pragma unroll
    for (int e = 0; e < 4; ++e) { v4u o; o.x = pk2(v[0][e], v[1][e]); o.y = pk2(v[2][e], v[3][e]); o.z = pk2(v[4][e], v[5][e]); o.w = pk2(v[6][e], v[7][e]);
        *(v4u*)(d + (size_t)e * t.ldt) = o; }
}

__device__ __forceinline__ void phase_A(const PL p, const Ctx& c, unsigned char* ws) {
    { LAS float* scs = (LAS float*)c.lds;
      LAS float* red = (LAS float*)(c.lds + 10240);
      float* PM = (float*)(ws + WS_PM);
      for (int item = c.bid; item < DEPTH * 48 * 8; item += c.G) {
        const int layer = item / 384, ksl = (item % 384) / 48, cg = item % 48, c4 = c.lane & 7, ks = c.lane >> 3, k0 = ksl * 256;
        __syncthreads();
        for (int i = c.tid; i < NB * 256; i += NTHREADS) { const int b = i >> 8, k = k0 + (i & 255);
            const float v = (b < BATCH) ? p.c_prompt()[b * D_MODEL + k] : p.c_sample()[(b - BATCH) * D_MODEL + k]; scs[i] = v / (1.0f + __expf(-v)); }
        __syncthreads();
        const float* W = p.w_ada() + (size_t)layer * D_MODEL * (N_MOD * D_MODEL) + (size_t)(k0 + ks) * (N_MOD * D_MODEL) + cg * 256 + c.wave * 32 + 4 * c4;
        f32x4 acc[NB];
#pragma unroll
        for (int b = 0; b < NB; ++b) acc[b] = (f32x4){0.f, 0.f, 0.f, 0.f};
        for (int i0 = 0; i0 < 32; i0 += 8) {
            f32x4 w[8];
#pragma unroll
            for (int i = 0; i < 8; ++i) w[i] = __builtin_nontemporal_load((const f32x4*)(W + (size_t)((i0 + i) * 8) * (N_MOD * D_MODEL)));
#pragma unroll
            for (int i = 0; i < 8; ++i) { const int kk = (i0 + i) * 8 + ks;
#pragma unroll
                for (int b = 0; b < NB; ++b) acc[b] = acc[b] + w[i] * scs[b * 256 + kk]; }
        }
#pragma unroll
        for (int b = 0; b < NB; ++b) *(LAS f32x4*)(red + ((c.wave * 8 + ks) * NB + b) * 32 + 4 * c4) = acc[b];
        __syncthreads();
        for (int i = c.tid; i < NB * 256; i += NTHREADS) { const int b = i >> 8, col = i & 255, w = col >> 5, cc = col & 31; float sm = 0.f;
#pragma unroll
            for (int k8 = 0; k8 < 8; ++k8) sm += red[((w * 8 + k8) * NB + b) * 32 + cc];
            PM[((size_t)(ksl * DEPTH + layer) * NB + b) * (N_MOD * D_MODEL) + cg * 256 + col] = sm; }
      }
      __syncthreads(); }
    for (int it = c.gw; it < N_TITEMS; it += c.NGW) {
        const TItem t0 = titem_desc(p, ws, it);
        f32x4 v0[8];
        titem_load(t0, c.lane, v0);
        titem_store(t0, c.lane, v0);
    }
    for (int it = c.gw; it < DEPTH * 2048; it += c.NGW) {
        const int l = it / 2048, kc = (it % 2048) / 32, nb = it % 32, k0 = kc * 8, g = k0 >> 7, c0 = k0 & 127, n = nb * 64 + c.lane;
        const float* wpg = p.w_pool_grp() + (size_t)l * 4 * 128 * 128 + (size_t)(g * 128 + c0) * 128;
        const float* ps = p.pool_scale() + (size_t)l * 512 + g * 128;
        const float* wpb = p.w_pool_br() + (size_t)l * 512 * D_MODEL + (size_t)(g * 128) * D_MODEL + n;
        float acc[8];
#pragma unroll
        for (int j = 0; j < 8; ++j) acc[j] = 0.f;
        for (int e = 0; e < 128; ++e) { const float wb = wpb[(size_t)e * D_MODEL] * ps[e];
#pragma unroll
            for (int j = 0; j < 8; ++j) acc[j] = fmaf(wpg[j * 128 + e], wb, acc[j]); }
        *(v4u*)((bf16*)(ws + WS_WTBR + l * SZ_WTBR) + (size_t)n * K_BR + k0) = pack8(acc);
    }
    if (c.bid == 0) { float* biasT = (float*)(ws + WS_BIAS);
        for (int i = c.tid; i < 3 * 4 * 129; i += NTHREADS) { const int g = i / (4 * 129), h = (i / 129) % 4, n = i % 129; biasT[i] = p.rel_bias()[p.bucket(g, n) * 12 + g * 4 + h]; } }
}

__device__ __forceinline__ void modsum_phase(const PL p, const Ctx& c, unsigned char* ws) {
    const float* PM = (const float*)(ws + WS_PM); float* mod = (float*)(ws + WS_MOD);
    constexpr int NTOT = DEPTH * NB * N_MOD * D_MODEL;
    for (int i = c.gw * 64 + c.lane; i < NTOT; i += c.NGW * 64) {
        float v[8];
#pragma unroll
        for (int s8 = 0; s8 < 8; ++s8) v[s8] = PM[(size_t)s8 * NTOT + i];
        const int layer = i / (NB * N_MOD * D_MODEL), col = i % (N_MOD * D_MODEL);
        mod[i] = ((v[0] + v[1]) + (v[2] + v[3])) + ((v[4] + v[5]) + (v[6] + v[7])) + p.b_ada()[(size_t)layer * (N_MOD * D_MODEL) + col]; }
}

__device__ __forceinline__ void rownorm_phase(const Ctx& c, const float* xin_p, const bf16* xin_pb, const float* xin_s, const bf16* y, const float* g_post, const float* mod_y, int i_gate,
                                              float* xout_p, bf16* xout_pb, float* xout_s, const float* g_pre, const float* mod_h, int i_shift, int i_scale, bf16* H) {
    for (int row = c.gw; row < MT; row += c.NGW) {
        int lane_ = c.lane; asm volatile("" : "+v"(lane_));
        const int cr = row < MP ? row / SEQ : BATCH + (row - MP);
        f32x4 x[8];
        if (row < MP && xin_pb) {
            const v2u* xb = (const v2u*)(xin_pb + (size_t)row * D_MODEL) + lane_;
#pragma unroll
            for (int j = 0; j < 8; ++j) { const v2u w = xb[64 * j]; x[j] = (f32x4){blo(w.x), bhi(w.x), blo(w.y), bhi(w.y)}; }
        } else {
            const f32x4* xr = (const f32x4*)(row < MP ? xin_p + (size_t)row * D_MODEL : xin_s + (size_t)(row - MP) * D_MODEL) + lane_;
#pragma unroll
            for (int j = 0; j < 8; ++j) x[j] = xr[64 * j];
        }
        if (y) {
            const v2u* yr = (const v2u*)(y + (size_t)row * D_MODEL) + lane_;
            const f32x4* gp = (const f32x4*)g_post + lane_;
            const f32x4* gt = (const f32x4*)(mod_y + (size_t)cr * (N_MOD * D_MODEL) + (size_t)i_gate * D_MODEL) + lane_;
            f32x4 v[8], gpv[8], gtv[8]; float ss = 0.f;
#pragma unroll
            for (int j = 0; j < 8; ++j) { const v2u yw = yr[64 * j]; v[j] = (f32x4){blo(yw.x), bhi(yw.x), blo(yw.y), bhi(yw.y)}; gpv[j] = gp[64 * j]; gtv[j] = gt[64 * j]; }
#pragma unroll
            for (int j = 0; j < 8; ++j) ss += (v[j].x * v[j].x + v[j].y * v[j].y) + (v[j].z * v[j].z + v[j].w * v[j].w);
            const float rstd = 1.0f / sqrtf(wave_sum(ss) * (1.0f / D_MODEL) + EPS);
#pragma unroll
            for (int j = 0; j < 8; ++j) x[j] = x[j] + gtv[j] * (v[j] * rstd * gpv[j]);
        }
        asm volatile("" ::: "memory");
        f32x4 g2[8], shv[8], slv[8];
        if (g_pre) {
            const f32x4* gp = (const f32x4*)g_pre + lane_;
            const f32x4* sh = (const f32x4*)(mod_h + (size_t)cr * (N_MOD * D_MODEL) + (size_t)i_shift * D_MODEL) + lane_;
            const f32x4* sl = (const f32x4*)(mod_h + (size_t)cr * (N_MOD * D_MODEL) + (size_t)i_scale * D_MODEL) + lane_;
#pragma unroll
            for (int j = 0; j < 8; ++j) { g2[j] = gp[64 * j]; shv[j] = sh[64 * j]; slv[j] = sl[64 * j]; }
        }
        if (y) {
            if (row < MP && xout_pb) { v2u* xo = (v2u*)(xout_pb + (size_t)row * D_MODEL) + lane_;
#pragma unroll
                for (int j = 0; j < 8; ++j) { v2u w; w.x = pk2(x[j].x, x[j].y); w.y = pk2(x[j].z, x[j].w); xo[64 * j] = w;
                    x[j] = (f32x4){blo(w.x), bhi(w.x), blo(w.y), bhi(w.y)}; }
            } else { f32x4* xo = (f32x4*)(row < MP ? xout_p + (size_t)row * D_MODEL : xout_s + (size_t)(row - MP) * D_MODEL) + lane_;
#pragma unroll
                for (int j = 0; j < 8; ++j) xo[64 * j] = x[j]; } }
        if (g_pre) {
            float ss = 0.f;
#pragma unroll
            for (int j = 0; j < 8; ++j) ss += (x[j].x * x[j].x + x[j].y * x[j].y) + (x[j].z * x[j].z + x[j].w * x[j].w);
            const float rstd = 1.0f / sqrtf(wave_sum(ss) * (1.0f / D_MODEL) + EPS);
            v2u* ho = (v2u*)(H + (size_t)row * D_MODEL) + lane_;
#pragma unroll
            for (int j = 0; j < 8; ++j) { const f32x4 hv = x[j] * rstd * g2[j] * (slv[j] + 1.0f) + shv[j]; v2u w; w.x = pk2(hv.x, hv.y); w.y = pk2(hv.z, hv.w); ho[64 * j] = w; }
        }
    }
}

template <class F>
__device__ __forceinline__ void gemv8(const Ctx& c, int fw, int nfw, const bf16* A8, int lda, int K, const bf16* Bt, int ldb, int N, const F f) {
    const int kc = K / 8;
    for (int n = fw; n < N; n += nfw) {
        float acc[8];
#pragma unroll
        for (int r = 0; r < 8; ++r) acc[r] = 0.f;
        const bf16* br = Bt + (size_t)n * ldb;
        for (int ch = c.lane; ch < kc; ch += 64) { const v4u b = *(const v4u*)(br + ch * 8);
            v4u a[8];
#pragma unroll
            for (int r = 0; r < 8; ++r) a[r] = *(const v4u*)(A8 + (size_t)r * lda + ch * 8);
#pragma unroll
            for (int r = 0; r < 8; ++r) acc[r] = dot8(a[r], b, acc[r]); }
        const float v = reduce8(acc, c.lane);
        if ((c.lane & 7) == 0) f(n, ((c.lane >> 5) & 1) * 4 + ((c.lane >> 4) & 1) * 2 + ((c.lane >> 3) & 1), v);
    }
}
__device__ __forceinline__ void gemv8_branch(const Ctx& c, const bf16* A8  , const bf16* Bt  , const bf16* Y1s  , bf16* MGs) {
    constexpr int kc = K_BR / 8;
    for (int n = c.gw; n < D_MODEL; n += c.NGW) {
        float acc[3][8];
#pragma unroll
        for (int s = 0; s < 3; ++s)
#pragma unroll
            for (int r = 0; r < 8; ++r) acc[s][r] = 0.f;
        const bf16* br = Bt + (size_t)n * K_BR;
#pragma unroll
        for (int s = 0; s < 3; ++s) { const int ch = c.lane + 64 * s;
            if (ch < kc) { const v4u b = *(const v4u*)(br + ch * 8);
                v4u a[8];
#pragma unroll
                for (int r = 0; r < 8; ++r) a[r] = *(const v4u*)(A8 + (size_t)r * K_BR + ch * 8);
#pragma unroll
                for (int r = 0; r < 8; ++r) acc[s][r] = dot8(a[r], b, acc[s][r]); } }
        const float v0 = reduce8(acc[0], c.lane), v1 = reduce8(acc[1], c.lane), v2 = reduce8(acc[2], c.lane);
        const int rr = ((c.lane >> 5) & 1) * 4 + ((c.lane >> 4) & 1) * 2 + ((c.lane >> 3) & 1);
        if ((c.lane & 7) == 0) { const bf16* gl = Y1s + (size_t)rr * N_IN + OFF_GL + n;
            const float m = sigmoidf_(bf2f(gl[0])) * v0 + sigmoidf_(bf2f(gl[D_MODEL])) * v1 + sigmoidf_(bf2f(gl[2 * D_MODEL])) * v2;
            MGs[(size_t)rr * D_MODEL + n] = (bf16)f2bf(m); }
    }
}

typedef short bf16x8_t __attribute__((ext_vector_type(8)));
typedef short s16x4_t __attribute__((ext_vector_type(4)));
typedef float f32x4_t __attribute__((ext_vector_type(4)));
constexpr int AT_RS = 160;
constexpr int AT_K = 0, AT_V = 256 * AT_RS, AT_BIAS = 2 * 256 * AT_RS;
__device__ __forceinline__ s16x4_t vtr(const LAS unsigned char* p) { return __builtin_bit_cast(s16x4_t, __builtin_amdgcn_ds_read_tr16_b64_v4i16((LAS s16x4_t*)p)); }
struct AttnPre { v4u kv[4], vv[4]; float bias; bf16x8_t q0, q1; };
__device__ __forceinline__ void attn_prefetch(const bf16* Y, const float* biasT, int item, int tid, AttnPre& P) {
    const int lane = tid & 63, w = __builtin_amdgcn_readfirstlane(tid >> 6);
    const int b = item / 384, g = (item / 128) % 3, h = (item / 32) % 4, idx = item % 32;
    const int dil = (g == 0) ? 1 : (g == 1 ? 4 : 16), nbc = 32 / dil, r = idx / nbc, i0 = (idx % nbc) * 128;
    const int co = g * 256 + h * 64;
    const bf16* Yb = Y + (size_t)b * SEQ * N_IN;
#pragma unroll
    for (int ps = 0; ps < 4; ++ps) { const int rowl = ps * 64 + (tid >> 3), ch = tid & 7, ik = i0 - 128 + rowl;
        P.kv[ps] = (v4u){0u, 0u, 0u, 0u}; P.vv[ps] = (v4u){0u, 0u, 0u, 0u};
        if (ik >= 0) { const bf16* src = Yb + (size_t)(ik * dil + r) * N_IN + co + ch * 8; P.kv[ps] = *(const v4u*)(src + OFF_K); P.vv[ps] = *(const v4u*)(src + OFF_V); } }
    P.bias = (tid < 129) ? biasT[(g * 4 + h) * 129 + tid] : 0.f;
    const int a = lane & 15, quad = lane >> 4, tq = (i0 + 16 * w + a) * dil + r;
    const bf16* qp = Yb + (size_t)tq * N_IN + OFF_Q + co + 8 * quad; P.q0 = *(const bf16x8_t*)qp; P.q1 = *(const bf16x8_t*)(qp + 32);
}
__device__ __forceinline__ void attn_block_items(const bf16* Y, const float* biasT, bf16* OG, float* LSE, int first, int step, int nitems, LAS unsigned char* lds, int tid) {
  if (first >= nitems) return;
  AttnPre P;
  attn_prefetch(Y, biasT, first, tid, P);
  for (int item = first;;) {
    const int lane = tid & 63, w = __builtin_amdgcn_readfirstlane(tid >> 6);
    const int b = item / 384, g = (item / 128) % 3, h = (item / 32) % 4, idx = item % 32;
    const int dil = (g == 0) ? 1 : (g == 1 ? 4 : 16), nbc = 32 / dil, r = idx / nbc, i0 = (idx % nbc) * 128;
#pragma unroll
    for (int ps = 0; ps < 4; ++ps) { const int rowl = ps * 64 + (tid >> 3), ch = tid & 7;
        *(LAS v4u*)(lds + AT_K + rowl * AT_RS + ch * 16) = P.kv[ps]; *(LAS v4u*)(lds + AT_V + rowl * AT_RS + ch * 16) = P.vv[ps]; }
    if (tid < 129) ((LAS float*)(lds + AT_BIAS))[tid] = P.bias;
    bf16x8_t qf[2]; qf[0] = P.q0; qf[1] = P.q1;
    __syncthreads();
    const int nxt = item + step;
    if (nxt < nitems) attn_prefetch(Y, biasT, nxt, tid, P);
    const int a = lane & 15, quad = lane >> 4;
    const int tq = (i0 + 16 * w + a) * dil + r;
    f32x4_t sc[9];
#pragma unroll
    for (int j = 0; j < 9; ++j) { const LAS unsigned char* kp = lds + AT_K + (16 * w + 16 * j + a) * AT_RS + 16 * quad;
        const bf16x8_t k0 = *(const LAS bf16x8_t*)kp, k1 = *(const LAS bf16x8_t*)(kp + 64);
        f32x4_t acc = (f32x4_t){0.f, 0.f, 0.f, 0.f};
        acc = __builtin_amdgcn_mfma_f32_16x16x32_bf16(k0, qf[0], acc, 0, 0, 0);
        acc = __builtin_amdgcn_mfma_f32_16x16x32_bf16(k1, qf[1], acc, 0, 0, 0);
        sc[j] = acc; }
    const LAS float* sb = (const LAS float*)(lds + AT_BIAS);
    float m = -1e30f;
#pragma unroll
    for (int j = 0; j < 9; ++j)
#pragma unroll
        for (int e = 0; e < 4; ++e) { const int kk = 16 * j + 4 * quad + e, dist = a + 128 - kk, ik = i0 + 16 * w - 128 + kk;
            const bool valid = (dist >= 0) && (dist <= 128) && (ik >= 0);
            const int dc = dist < 0 ? 0 : (dist > 128 ? 128 : dist);
            const float s = valid ? sc[j][e] * 0.125f + sb[dc] : -1e30f;
            sc[j][e] = s; m = fmaxf(m, s); }
    m = fmaxf(m, __shfl_xor(m, 16)); m = fmaxf(m, __shfl_xor(m, 32));
    float l = 0.f;
#pragma unroll
    for (int j = 0; j < 9; ++j)
#pragma unroll
        for (int e = 0; e < 4; ++e) { const float pv = (sc[j][e] > -1e29f) ? __expf(sc[j][e] - m) : 0.f; sc[j][e] = pv; l += pv; }
    l += __shfl_xor(l, 16); l += __shfl_xor(l, 32);
    f32x4_t oacc[4];
#pragma unroll
    for (int dt = 0; dt < 4; ++dt) oacc[dt] = (f32x4_t){0.f, 0.f, 0.f, 0.f};
    const LAS unsigned char* vbase = lds + AT_V + (16 * w + 4 * quad + ((lane & 15) >> 2)) * AT_RS + 8 * (lane & 3);
#pragma unroll
    for (int ss = 0; ss < 5; ++ss) {
        v4u pw; pw.x = pk2(sc[2 * ss][0], sc[2 * ss][1]); pw.y = pk2(sc[2 * ss][2], sc[2 * ss][3]);
        if (ss < 4) { pw.z = pk2(sc[2 * ss + 1][0], sc[2 * ss + 1][1]); pw.w = pk2(sc[2 * ss + 1][2], sc[2 * ss + 1][3]); } else { pw.z = 0u; pw.w = 0u; }
        const bf16x8_t pb = __builtin_bit_cast(bf16x8_t, pw);
#pragma unroll
        for (int dt = 0; dt < 4; ++dt) {
            const s16x4_t lo = vtr(vbase + (32 * ss) * AT_RS + 32 * dt);
            s16x4_t hi = (s16x4_t){0, 0, 0, 0};
            if (ss < 4) hi = vtr(vbase + (32 * ss + 16) * AT_RS + 32 * dt);
            bf16x8_t va; va[0] = lo[0]; va[1] = lo[1]; va[2] = lo[2]; va[3] = lo[3]; va[4] = hi[0]; va[5] = hi[1]; va[6] = hi[2]; va[7] = hi[3];
            oacc[dt] = __builtin_amdgcn_mfma_f32_16x16x32_bf16(va, pb, oacc[dt], 0, 0, 0);
        }
    }
    const float il = 1.0f / l;
    bf16* op = OG + ((size_t)(b * SEQ + tq) * 3 + g) * 256 + h * 64 + 4 * quad;
#pragma unroll
    for (int dt = 0; dt < 4; ++dt) { v2u o; o.x = pk2(oacc[dt][0] * il, oacc[dt][1] * il); o.y = pk2(oacc[dt][2] * il, oacc[dt][3] * il); *(v2u*)(op + 16 * dt) = o; }
    if (quad == 0) LSE[((size_t)(b * SEQ + tq) * 3 + g) * 4 + h] = m + __logf(l);
    __syncthreads();
    if (nxt >= nitems) break;
    item = nxt;
  }
}
__device__ __forceinline__ void attn_combine_phase(const Ctx& c, const bf16* OG, const float* LSE, bf16* A2) {
    const int h = c.lane >> 4, d4 = (c.lane & 15) * 4;
    for (int tok = c.gw; tok < MT; tok += c.NGW) {
        const float l0 = LSE[(size_t)tok * 12 + h], l1 = LSE[(size_t)tok * 12 + 4 + h], l2 = LSE[(size_t)tok * 12 + 8 + h];
        const float mm = fmaxf(l0, fmaxf(l1, l2));
        const float w0 = __expf(l0 - mm), w1 = __expf(l1 - mm), w2 = __expf(l2 - mm), iw = 1.0f / (w0 + w1 + w2);
        const bf16* op = OG + (size_t)tok * 768 + h * 64 + d4;
        const v2u a0 = *(const v2u*)op, a1 = *(const v2u*)(op + 256), a2 = *(const v2u*)(op + 512);
        v2u o;
        o.x = pk2((w0 * blo(a0.x) + w1 * blo(a1.x) + w2 * blo(a2.x)) * iw, (w0 * bhi(a0.x) + w1 * bhi(a1.x) + w2 * bhi(a2.x)) * iw);
        o.y = pk2((w0 * blo(a0.y) + w1 * blo(a1.y) + w2 * blo(a2.y)) * iw, (w0 * bhi(a0.y) + w1 * bhi(a1.y) + w2 * bhi(a2.y)) * iw);
        *(v2u*)(A2 + (size_t)tok * K_BR + 1024 + h * 64 + d4) = o;
    }
}
__device__ __forceinline__ void attn_sample_item(const PL p, const bf16* Y, const float* biasT, bf16* OG, float* LSE, int layer, int bs, int h, int g, LAS float* ps, int lane) {
    const int row = MP + bs;
    const int dil = (g == 0) ? 1 : (g == 1 ? 4 : 16), Lc = 128 * dil;
    const float* cache = (g == 0 ? p.c128() : (g == 1 ? p.c512() : p.c2048())) + (size_t)(layer * DEC_BATCH + bs) * Lc * 512;
    const int co = g * 256 + h * 64;
    float q[64];
    { const v4u* qp = (const v4u*)(Y + (size_t)row * N_IN + OFF_Q + co);
#pragma unroll
      for (int i = 0; i < 8; ++i) { float f[8]; unpack8(qp[i], f);
#pragma unroll
          for (int e = 0; e < 8; ++e) q[8 * i + e] = f[e]; } }
    float s[3];
#pragma unroll
    for (int j = 0; j < 3; ++j) { const int n = lane + 64 * j; s[j] = -1e30f;
        if (n <= 128) { float d = 0.f;
            if (n == 0) { const v4u* kp = (const v4u*)(Y + (size_t)row * N_IN + OFF_K + co);
#pragma unroll
                for (int i = 0; i < 8; ++i) { float f[8]; unpack8(kp[i], f);
#pragma unroll
                    for (int e = 0; e < 8; ++e) d = fmaf(q[8 * i + e], f[e], d); } }
            else { const f32x4* kp = (const f32x4*)(cache + (size_t)(Lc - n * dil) * 512 + h * 64);
#pragma unroll
                for (int i = 0; i < 16; ++i) { const f32x4 kv = kp[i]; d = fmaf(q[4 * i], kv.x, d); d = fmaf(q[4 * i + 1], kv.y, d); d = fmaf(q[4 * i + 2], kv.z, d); d = fmaf(q[4 * i + 3], kv.w, d); } }
            s[j] = d * 0.125f + biasT[(g * 4 + h) * 129 + n]; } }
    const float m = wave_max(fmaxf(s[0], fmaxf(s[1], s[2])));
    float pj[3], l = 0.f;
#pragma unroll
    for (int j = 0; j < 3; ++j) { pj[j] = (s[j] > -1e29f) ? __expf(s[j] - m) : 0.f; l += pj[j]; }
    l = wave_sum(l);
    LDS_FENCE();
#pragma unroll
    for (int j = 0; j < 3; ++j) ps[lane + 64 * j] = pj[j];
    LDS_FENCE();
    const int d4 = 4 * (lane & 15), kq = lane >> 4;
    f32x4 o = (f32x4){0.f, 0.f, 0.f, 0.f};
    const float* vb = cache + (size_t)Lc * 512 + 256 + h * 64 + d4;
#pragma unroll 8
    for (int i = 0; i < 32; ++i) { const int n = 4 * i + kq + 1; const f32x4 vv = *(const f32x4*)(vb - (long)n * dil * 512); o = o + vv * ps[n]; }
    if (kq == 0) { const v2u w = *(const v2u*)(Y + (size_t)row * N_IN + OFF_V + co + d4); const float p0 = ps[0];
        o.x = fmaf(p0, blo(w.x), o.x); o.y = fmaf(p0, bhi(w.x), o.y); o.z = fmaf(p0, blo(w.y), o.z); o.w = fmaf(p0, bhi(w.y), o.w); }
#pragma unroll
    for (int e = 0; e < 4; ++e) { float t = o[e]; t += __shfl_xor(t, 16); t += __shfl_xor(t, 32); o[e] = t; }
    const float il = 1.0f / l;
    if (kq == 0) { v2u w; w.x = pk2(o.x * il, o.y * il); w.y = pk2(o.z * il, o.w * il); *(v2u*)(OG + ((size_t)row * 3 + g) * 256 + h * 64 + d4) = w; }
    if (lane == 0) LSE[((size_t)row * 3 + g) * 4 + h] = m + __logf(l);
    LDS_FENCE();
}
__device__ __forceinline__ void poolconv_row(const PL p, const bf16* Y, bf16* A2, int layer, int row, int lane) {
    const bf16* yr = Y + (size_t)row * N_IN;
    const int c0 = lane * 8, w = 2 << (lane >> 4);
    float cur[8], s[8];
    unpack8(*(const v4u*)(yr + OFF_P + c0), cur);
#pragma unroll
    for (int j = 0; j < 8; ++j) s[j] = cur[j];
    float inv;
    if (row < MP) { const int t = row % SEQ, cnt = (t + 1 < w) ? (t + 1) : w;
        for (int i = 1; i < cnt; ++i) { float f[8]; unpack8(*(const v4u*)(yr - (size_t)i * N_IN + OFF_P + c0), f);
#pragma unroll
            for (int j = 0; j < 8; ++j) s[j] += f[j]; }
        inv = 1.0f / (float)cnt;
    } else { const float* st = p.state_pool() + (size_t)(layer * DEC_BATCH + (row - MP)) * 15 * 512 + c0;
        for (int i = 1; i < w; ++i) { const f32x4 a = *(const f32x4*)(st + (size_t)(15 - i) * 512), b = *(const f32x4*)(st + (size_t)(15 - i) * 512 + 4);
            s[0] += a.x; s[1] += a.y; s[2] += a.z; s[3] += a.w; s[4] += b.x; s[5] += b.y; s[6] += b.z; s[7] += b.w; }
        inv = 1.0f / (float)w; }
    float pm[8];
#pragma unroll
    for (int j = 0; j < 8; ++j) pm[j] = s[j] * inv - cur[j];
    float gb[8], gc[8], hc[8], u0[8], u1[8], u2[8];
    unpack8(*(const v4u*)(yr + OFF_GB + c0), gb); unpack8(*(const v4u*)(yr + OFF_GC + c0), gc); unpack8(*(const v4u*)(yr + OFF_HC + c0), hc);
#pragma unroll
    for (int j = 0; j < 8; ++j) { u0[j] = gc[j] * hc[j]; u1[j] = 0.f; u2[j] = 0.f; }
    if (row < MP) { const int t = row % SEQ;
        if (t >= 1) { unpack8(*(const v4u*)(yr - N_IN + OFF_GC + c0), gc); unpack8(*(const v4u*)(yr - N_IN + OFF_HC + c0), hc);
#pragma unroll
            for (int j = 0; j < 8; ++j) u1[j] = gc[j] * hc[j]; }
        if (t >= 2) { unpack8(*(const v4u*)(yr - 2 * N_IN + OFF_GC + c0), gc); unpack8(*(const v4u*)(yr - 2 * N_IN + OFF_HC + c0), hc);
#pragma unroll
            for (int j = 0; j < 8; ++j) u2[j] = gc[j] * hc[j]; }
    } else { const float* st = p.state_conv() + (size_t)(layer * DEC_BATCH + (row - MP)) * 2 * 512 + c0;
#pragma unroll
        for (int j = 0; j < 8; ++j) { u2[j] = st[j]; u1[j] = st[512 + j]; } }
    const float* cw = p.conv_w() + (size_t)layer * 3 * 512 + c0;
    float cb[8];
#pragma unroll
    for (int j = 0; j < 8; ++j) cb[j] = gb[j] * (u2[j] * cw[j] + u1[j] * cw[512 + j] + u0[j] * cw[1024 + j]);
    *(v4u*)(A2 + (size_t)row * K_BR + c0) = pack8(pm);
    *(v4u*)(A2 + (size_t)row * K_BR + 512 + c0) = pack8(cb);
}
__device__ __forceinline__ void mixer_phase(const PL p, const Ctx& c, int layer, unsigned char* ws, float* outp) {
    const bf16* Y = (const bf16*)(ws + WS_Y); bf16* A2 = (bf16*)(ws + WS_A2); const float* biasT = (const float*)(ws + WS_BIAS);
    LAS float* ps = (LAS float*)(c.lds + c.wave * 1024);
    float* out = outp;
    const int gtid = c.gw * 64 + c.lane, gsz = c.NGW * 64;
    { constexpr int NQ = BATCH * (128 + 512 + 2048) * 64;
      for (int q0 = gtid; q0 < NQ; q0 += 4 * gsz) {
          v4u v[4]; float* dst[4];
#pragma unroll
          for (int u = 0; u < 4; ++u) { const int q = q0 + u * gsz; dst[u] = nullptr;
              if (q < NQ) { const int pidx = q >> 6, ch = q & 63, b = pidx / 2688, pp = pidx % 2688, g = pp < 128 ? 0 : (pp < 640 ? 1 : 2), j = pp - (g == 0 ? 0 : (g == 1 ? 128 : 640)), w = 128 << (2 * g);
                  v[u] = *(const v4u*)(Y + (size_t)(b * SEQ + SEQ - w + j) * N_IN + ((ch >> 5) ? OFF_V : OFF_K) + g * 256 + (ch & 31) * 8);
                  dst[u] = out + (g == 0 ? O_KVP0 : (g == 1 ? O_KVP1 : O_KVP2)) + (size_t)layer * (BATCH * w * 512) + ((size_t)(b * w + j) * 512 + ch * 8); } }
#pragma unroll
          for (int u = 0; u < 4; ++u) if (dst[u]) { float f[8]; unpack8(v[u], f); *(f32x4*)dst[u] = (f32x4){f[0], f[1], f[2], f[3]}; *(f32x4*)(dst[u] + 4) = (f32x4){f[4], f[5], f[6], f[7]}; } } }
    { constexpr int N0 = 3 * DEC_BATCH * 512, N1 = N0 + BATCH * 15 * 512, N2 = N1 + DEC_BATCH * 15 * 512, N3 = N2 + BATCH * 2 * 512, N4 = N3 + DEC_BATCH * 2 * 512;
      static_assert(N4 <= 256 * NTHREADS, "one element per thread");
      int i = gtid; float val = 0.f; float* dst = nullptr;
      if (i < N0) { const int g = i / (DEC_BATCH * 512), ii = i % (DEC_BATCH * 512), hd = ii & 255, kv = (ii >> 8) & 1, b = ii >> 9;
          val = bf2f(Y[(size_t)(MP + b) * N_IN + (kv ? OFF_V : OFF_K) + g * 256 + hd]); dst = out + (g == 0 ? O_KVS0 : (g == 1 ? O_KVS1 : O_KVS2)) + (size_t)layer * DEC_BATCH * 512 + ii; }
      else if (i < N1) { i -= N0; const int cc = i & 511, j = (i >> 9) % 15, b = (i >> 9) / 15;
          val = bf2f(Y[(size_t)(b * SEQ + SEQ - 15 + j) * N_IN + OFF_P + cc]); dst = out + O_POOLP + (size_t)layer * BATCH * 15 * 512 + i; }
      else if (i < N2) { i -= N1; const int cc = i & 511, j = (i >> 9) % 15, b = (i >> 9) / 15;
          val = (j < 14) ? p.state_pool()[((size_t)(layer * DEC_BATCH + b) * 15 + j + 1) * 512 + cc] : bf2f(Y[(size_t)(MP + b) * N_IN + OFF_P + cc]); dst = out + O_POOLS + (size_t)layer * DEC_BATCH * 15 * 512 + i; }
      else if (i < N3) { i -= N2; const int cc = i & 511, j = (i >> 9) & 1, b = i >> 10; const bf16* yr = Y + (size_t)(b * SEQ + SEQ - 2 + j) * N_IN;
          val = bf2f(yr[OFF_GC + cc]) * bf2f(yr[OFF_HC + cc]); dst = out + O_CONVP + (size_t)layer * BATCH * 2 * 512 + i; }
      else if (i < N4) { i -= N3; const int cc = i & 511, j = (i >> 9) & 1, b = i >> 10; const bf16* yr = Y + (size_t)(MP + b) * N_IN;
          val = (j == 0) ? p.state_conv()[((size_t)(layer * DEC_BATCH + b) * 2 + 1) * 512 + cc] : bf2f(yr[OFF_GC + cc]) * bf2f(yr[OFF_HC + cc]); dst = out + O_CONVS + (size_t)layer * DEC_BATCH * 2 * 512 + i; }
      if (dst) *dst = val; }
    constexpr int NB0 = 32;
    if (c.bid < NB0) return;
    const int mb = c.bid - NB0, mG = c.G - NB0, mgw = mb * NWAVES + c.wave, mNGW = mG * NWAVES;
    for (int row = mgw; row < MT; row += mNGW) poolconv_row(p, Y, A2, layer, row, c.lane);
    if (c.wave == 0 && mb < DEC_BATCH * 12) { const int it = mb; attn_sample_item(p, Y, biasT, (bf16*)(ws + WS_OG), (float*)(ws + WS_LSE), layer, it / 12, (it / 3) % 4, it % 3, ps, c.lane); }
    __syncthreads();
    attn_block_items(Y, biasT, (bf16*)(ws + WS_OG), (float*)(ws + WS_LSE), mb, mG, BATCH * 3 * 4 * 32, c.lds, c.tid);
}

__device__ __forceinline__ void ffnact_phase(const PL p, const Ctx& c, int layer, unsigned char* ws, float* outp) {
    const bf16* UP = (const bf16*)(ws + WS_Y); bf16* ACT = (bf16*)(ws + WS_ACT);
    const float* fw = p.ffn_conv_w() + (size_t)layer * 3 * N_UP;
    const int gtid = c.gw * 64 + c.lane, gsz = c.NGW * 64;
    constexpr int CH = D_FF / 8;
    for (int idx = gtid; idx < (MP / 32 + DEC_BATCH) * CH; idx += gsz) {
        const int ri = idx / CH, j0 = (idx % CH) * 8, row = ri < MP / 32 ? (ri >> 1) * 64 + (ri & 1) : MP + (ri - MP / 32);
        const bf16* r0 = UP + (size_t)row * N_UP;
        float a[8], b[8], ga[8], va[8];
        unpack8(*(const v4u*)(r0 + j0), ga); unpack8(*(const v4u*)(r0 + D_FF + j0), va);
#pragma unroll
        for (int j = 0; j < 8; ++j) { a[j] = ga[j] * fw[2 * N_UP + j0 + j]; b[j] = va[j] * fw[2 * N_UP + D_FF + j0 + j]; }
        if (row < MP) { const int t = row % SEQ;
            if (t >= 1) { unpack8(*(const v4u*)(r0 - N_UP + j0), ga); unpack8(*(const v4u*)(r0 - N_UP + D_FF + j0), va);
#pragma unroll
                for (int j = 0; j < 8; ++j) { a[j] = fmaf(ga[j], fw[N_UP + j0 + j], a[j]); b[j] = fmaf(va[j], fw[N_UP + D_FF + j0 + j], b[j]); } }
            if (t >= 2) { unpack8(*(const v4u*)(r0 - 2 * N_UP + j0), ga); unpack8(*(const v4u*)(r0 - 2 * N_UP + D_FF + j0), va);
#pragma unroll
                for (int j = 0; j < 8; ++j) { a[j] = fmaf(ga[j], fw[j0 + j], a[j]); b[j] = fmaf(va[j], fw[D_FF + j0 + j], b[j]); } }
        } else { const float* st = p.state_ffn() + (size_t)(layer * DEC_BATCH + (row - MP)) * 2 * N_UP;
#pragma unroll
            for (int j = 0; j < 8; ++j) { a[j] = fmaf(st[N_UP + j0 + j], fw[N_UP + j0 + j], a[j]); b[j] = fmaf(st[N_UP + D_FF + j0 + j], fw[N_UP + D_FF + j0 + j], b[j]);
                                          a[j] = fmaf(st[j0 + j], fw[j0 + j], a[j]); b[j] = fmaf(st[D_FF + j0 + j], fw[D_FF + j0 + j], b[j]); } }
        float o[8];
#pragma unroll
        for (int j = 0; j < 8; ++j) o[j] = gelu_tanh(a[j]) * b[j];
        *(v4u*)(ACT + (size_t)row * D_FF + j0) = pack8(o);
    }
    float* out = outp;
    for (int i = gtid; i < BATCH * 2 * N_UP; i += gsz) { const int cc = i % N_UP, j = (i / N_UP) & 1, b = i / (2 * N_UP);
        out[O_FFNP + (size_t)layer * BATCH * 2 * N_UP + i] = bf2f(UP[(size_t)(b * SEQ + SEQ - 2 + j) * N_UP + cc]); }
    for (int i = gtid; i < DEC_BATCH * 2 * N_UP; i += gsz) { const int cc = i % N_UP, j = (i / N_UP) & 1, b = i / (2 * N_UP);
        out[O_FFNS + (size_t)layer * DEC_BATCH * 2 * N_UP + i] = (j == 0) ? p.state_ffn()[((size_t)(layer * DEC_BATCH + b) * 2 + 1) * N_UP + cc] : bf2f(UP[(size_t)(MP + b) * N_UP + cc]); }
}


#define XB_TMO      128
#define XB_XCNT(j)  (256  + 64 * (j))
#define XB_XSUB(j)  (1280 + 64 * (j))
#define XB_XGEN(j)  (2304 + 64 * (j))
#define XB_TOP      3328
#define XB_TOPGEN   3392
#define XCD_BAR_WORDS 3456
#define XB_SPIN_CAP (1u << 22)
__device__ __forceinline__ unsigned xb_ld(unsigned* p)              { return __hip_atomic_load(p, __ATOMIC_RELAXED, __HIP_MEMORY_SCOPE_AGENT); }
__device__ __forceinline__ unsigned xb_add(unsigned* p, unsigned v) { return __hip_atomic_fetch_add(p, v, __ATOMIC_RELAXED, __HIP_MEMORY_SCOPE_AGENT); }
__device__ __forceinline__ unsigned xb_xcc_id() { return (unsigned)__builtin_amdgcn_s_getreg((3 << 11) | 20) & 0xFu; }
#define XB_SPIN(cond, bar) do { unsigned _sp = 0; while (cond) { __builtin_amdgcn_s_sleep(1); \
    if ((++_sp & 255u) == 0u) { if (xb_ld(&(bar)[XB_TMO])) break; if (_sp > XB_SPIN_CAP) { atomicAdd(&(bar)[XB_TMO], 1u); break; } } } } while (0)
__device__ __forceinline__ void xcd_barrier_complete(unsigned* bar, unsigned x, unsigned G, unsigned& nloc, unsigned& nx) {
    unsigned sum, cnt, mine, sp = 0u;
    for (;;) {
        sum = 0u; cnt = 0u; mine = 0u;
#pragma unroll
        for (unsigned j = 0; j < 16; ++j) { const unsigned c = xb_ld(&bar[XB_XCNT(j)]); sum += c; cnt += (c > 0u) ? 1u : 0u; mine = (j == x) ? c : mine; }
        if (sum == G) break;
        __builtin_amdgcn_s_sleep(1);
        if ((++sp & 255u) == 0u) { if (xb_ld(&bar[XB_TMO])) break; if (sp > XB_SPIN_CAP) { atomicAdd(&bar[XB_TMO], 1u); break; } }
    }
    nloc = mine > 0u ? mine : 1u; nx = cnt > 0u ? cnt : 1u;
}
__device__ __forceinline__ void xcd_barrier(unsigned* bar, volatile LAS unsigned* st, unsigned G) {
    asm volatile("s_waitcnt vmcnt(0)" ::: "memory");
    __syncthreads();
    if (threadIdx.x == 0) {
        const unsigned x = xb_xcc_id();
        __builtin_amdgcn_s_waitcnt(0);
        unsigned nloc = st[0], nx = st[1];
        if (nloc == 0u) { xcd_barrier_complete(bar, x, G, nloc, nx); st[0] = nloc; st[1] = nx;
            bool even = (nx == 8u);
#pragma unroll
            for (unsigned j = 0; j < 8; ++j) even = even && (xb_ld(&bar[XB_XCNT(j)]) * 8u == G);
            st[4] = even ? 1u : 0u; }
        const unsigned old = xb_add(&bar[XB_XSUB(x)], 1u);
        const unsigned gen = old / nloc;
        if (old + 1u == (gen + 1u) * nloc) {
            __builtin_amdgcn_fence(__ATOMIC_RELEASE, "agent");
            asm volatile("s_waitcnt vmcnt(0)" ::: "memory");
            const unsigned og = xb_add(&bar[XB_TOP], 1u);
            const unsigned tg = og / nx;
            if (og + 1u == (tg + 1u) * nx) xb_add(&bar[XB_TOPGEN], 1u);
            else XB_SPIN(xb_ld(&bar[XB_TOPGEN]) == tg, bar);
            __builtin_amdgcn_fence(__ATOMIC_ACQUIRE, "agent");
            xb_add(&bar[XB_XGEN(x)], 1u);
            asm volatile("s_waitcnt vmcnt(0)" ::: "memory");
        } else {
            XB_SPIN(xb_ld(&bar[XB_XGEN(x)]) == gen, bar);
            __builtin_amdgcn_fence(__ATOMIC_ACQUIRE, "agent");
            asm volatile("s_waitcnt vmcnt(0)" ::: "memory");
        }
    }
    __syncthreads();
}

constexpr int PPL = 10;
constexpr int N_PHASES = 3 + DEPTH * PPL;
__global__ void __launch_bounds__(NTHREADS, 2) mk_fwd(Params prm) {
    extern __shared__ __attribute__((aligned(16))) unsigned char lds_raw[];
    { const unsigned* src = (const unsigned*)&prm; LAS unsigned* dst = (LAS unsigned*)((LAS unsigned char*)lds_raw + PARAM_LDS_OFF);
      for (int i = threadIdx.x; i < (int)(sizeof(Params) / 4); i += NTHREADS) dst[i] = src[i]; }
    volatile LAS unsigned* bar_st = (volatile LAS unsigned*)((LAS unsigned char*)lds_raw + 131072 + 512);
    if (threadIdx.x == 0) { bar_st[0] = 0u; bar_st[1] = 0u; bar_st[2] = 0u; bar_st[3] = 0u; bar_st[4] = 0u; }
    __syncthreads();
    const int ph_lo = prm.ph_lo, ph_hi = prm.ph_hi + prm.rc, rp = prm.rp, rc = prm.rc;
    if (ph_hi - ph_lo > 1 && threadIdx.x == 0) { const unsigned x = xb_xcc_id(); bar_st[2] = xb_add((unsigned*)(prm.ws + WS_CTL) + XB_XCNT(x), 1u); bar_st[3] = x; }
    for (int it = ph_lo; it < ph_hi; ++it) {
        const int ph = (it <= rp) ? it : (it <= rp + rc ? rp : it - rc);
        int tid_ = threadIdx.x, bid_ = blockIdx.x, G_ = gridDim.x;
        int lz_ = 0; asm volatile("" : "+s"(lz_));
        volatile LAS unsigned* bst = bar_st + lz_;
        if (bst[4] != 0u) bid_ = (int)(bst[2] * 8u + bst[3]);
        bid_ = __builtin_amdgcn_readfirstlane(bid_);
        PL p; p.b = (LAS const unsigned char*)lds_raw + PARAM_LDS_OFF + lz_; asm volatile("" ::: "memory");

        unsigned char* ws = (unsigned char*)p.ldp((int)offsetof(Params, ws)); float* outp = (float*)p.ldp((int)offsetof(Params, out));
        asm volatile("" : "+v"(tid_)); asm volatile("" : "+s"(bid_)); asm volatile("" : "+s"(G_));
        Ctx c;
        c.lds = (LAS unsigned char*)lds_raw; c.tid = tid_; c.lane = tid_ & 63; c.wave = __builtin_amdgcn_readfirstlane(tid_ >> 6);
        c.bid = bid_; c.G = G_; c.gw = bid_ * NWAVES + c.wave; c.NGW = G_ * NWAVES;
        const int G = G_;
        bf16* H = (bf16*)(ws + WS_H); bf16* Y = (bf16*)(ws + WS_Y); bf16* A2 = (bf16*)(ws + WS_A2); bf16* T = (bf16*)(ws + WS_T);
        bf16* MG = (bf16*)(ws + WS_MG); bf16* ACT = (bf16*)(ws + WS_ACT); float* XS = (float*)(ws + WS_XS); bf16* XB = (bf16*)(ws + WS_XB);
        const float* modb = (const float*)(ws + WS_MOD);
        float* yp = outp + O_YP; float* ys = outp + O_YS;
        if (ph == 0) phase_A(p, c, ws);
        else if (ph == 1) modsum_phase(p, c, ws);
        else if (ph == 2) rownorm_phase(c, p.x_prompt(), nullptr, p.x_sample(), nullptr, nullptr, nullptr, 0, nullptr, nullptr, nullptr, p.norm_g(), modb, 0, 1, H);
        else {
            const int l = (ph - 3) / PPL, spx = (ph - 3) % PPL, sp = spx <= 1 ? spx : spx - 1;
            const float* mod = modb + (size_t)l * NB * N_MOD * D_MODEL;
            const float* ng = p.norm_g() + (size_t)l * 4 * D_MODEL;
            const bf16* WTin = (const bf16*)(ws + WS_WTIN + l * SZ_WTIN); const bf16* WTbr = (const bf16*)(ws + WS_WTBR + l * SZ_WTBR);
            const bf16* WTo = (const bf16*)(ws + WS_WTO + l * SZ_WTO); const bf16* WTup = (const bf16*)(ws + WS_WTUP + l * SZ_WTUP); const bf16* WTdn = (const bf16*)(ws + WS_WTDN + l * SZ_WTDN);
            pg8::StaticOrder S;
            if (spx == 2) {
                attn_combine_phase(c, (const bf16*)(ws + WS_OG), (const float*)(ws + WS_LSE), A2);
            } else if (sp == 0) {
                pg8::Gemm g{H, WTin, MP, N_IN - 256, D_MODEL, D_MODEL, D_MODEL}; S.init(g, G, c.bid);
                pg8::EpiBf16 E{Y, N_IN};
                pg8::gemm_phase<pg8::EpiBf16, true>(c.lds, c.tid, g, S, E);
                gemv8(c, c.gw, c.NGW, H + (size_t)MP * D_MODEL, D_MODEL, D_MODEL, WTin, D_MODEL, N_IN, StBf16{Y + (size_t)MP * N_IN, N_IN});
            } else if (sp == 1) {
                { pg8::Gemm g{H, WTin + (size_t)(N_IN - 256) * D_MODEL, MP, 256, D_MODEL, D_MODEL, D_MODEL}; S.init(g, G, c.bid);
                  pg8::EpiBf16 E{Y + (N_IN - 256), N_IN};
                  pg8::gemm_phase<pg8::EpiBf16, true>(c.lds, c.tid, g, S, E); }
                mixer_phase(p, c, l, ws, outp);
            } else if (sp == 2) {
                { pg8::Gemm g{A2, WTbr, MP, D_MODEL, K_BR, K_BR, K_BR}; pg8::SegOrder S3; S3.init(g, c.bid);
                  pg8::EpiGate E{Y + OFF_GL, N_IN, MG};
                  pg8::gemm_phase<pg8::EpiGate, true>(c.lds, c.tid, g, S3, E); }
                gemv8_branch(c, A2 + (size_t)MP * K_BR, WTbr, Y + (size_t)MP * N_IN, MG + (size_t)MP * D_MODEL);
            } else if (sp == 3) {
                pg8::Gemm g{MG, WTo, MP, D_MODEL, D_MODEL, D_MODEL, D_MODEL}; S.init(g, G, c.bid);
                pg8::EpiBf16 E{T, D_MODEL};
                pg8::gemm_phase<pg8::EpiBf16, false>(c.lds, c.tid, g, S, E);
                gemv8(c, c.gw, c.NGW, MG + (size_t)MP * D_MODEL, D_MODEL, D_MODEL, WTo, D_MODEL, D_MODEL, StBf16{T + (size_t)MP * D_MODEL, D_MODEL});
            } else if (sp == 4) {
                rownorm_phase(c, p.x_prompt(), l == 0 ? (const bf16*)nullptr : XB, l == 0 ? p.x_sample() : ys, T, ng + D_MODEL, mod, 2, nullptr, XB, XS, ng + 2 * D_MODEL, mod, 3, 4, H);
            } else if (sp == 5) {
                pg8::Gemm g{H, WTup, MP, N_UP, D_MODEL, D_MODEL, D_MODEL}; S.init(g, G, c.bid);
                EpiFfn E{ACT, Y, p.ffn_conv_w() + (size_t)l * 3 * N_UP};
                pg8::gemm_phase<EpiFfn, true>(c.lds, c.tid, g, S, E);
                if (c.bid >= 128) gemv8(c, (c.bid - 128) * NWAVES + c.wave, (c.G - 128) * NWAVES, H + (size_t)MP * D_MODEL, D_MODEL, D_MODEL, WTup, D_MODEL, N_UP, StBf16Up{Y + (size_t)MP * N_UP});
            } else if (sp == 6) {
                ffnact_phase(p, c, l, ws, outp);
            } else if (sp == 7) {
                pg8::Gemm g{ACT, WTdn, MP, D_MODEL, D_FF, D_FF, D_FF}; S.init(g, G, c.bid);
                pg8::EpiBf16 E{T, D_MODEL};
                pg8::gemm_phase<pg8::EpiBf16, false>(c.lds, c.tid, g, S, E);
                gemv8(c, c.gw, c.NGW, ACT + (size_t)MP * D_FF, D_FF, D_FF, WTdn, D_FF, D_MODEL, StBf16{T + (size_t)MP * D_MODEL, D_MODEL});
            } else {
                const bool lastl = (l == DEPTH - 1);
                rownorm_phase(c, nullptr, XB, XS, T, ng + 3 * D_MODEL, mod, 5, yp, lastl ? (bf16*)nullptr : XB, ys, lastl ? nullptr : p.norm_g() + (size_t)(l + 1) * 4 * D_MODEL, modb + (size_t)(l + 1) * NB * N_MOD * D_MODEL, 0, 1, H);
            }
        }
        if (it + 1 < ph_hi) xcd_barrier((unsigned*)(ws + WS_CTL), bst, (unsigned)G_);
    }
}

extern "C" void kernel_launch(void* const* d_in, const int* in_sizes, int n_in, void* d_out, int out_size, void* d_ws, size_t ws_size, hipStream_t stream) {
    static int grid = 0;
    if (grid == 0) {
        if (n_in != 25 || (size_t)out_size != O_END || ws_size < WS_END) { fprintf(stderr, "kernel_launch: unexpected sizes n_in %d out %d (want %zu) ws %zu (want %zu)\n", n_in, out_size, (size_t)O_END, ws_size, (size_t)WS_END); grid = -1; return; }
        int dev = 0, cus = 0, per_cu = 0;
        hipGetDevice(&dev); hipDeviceGetAttribute(&cus, hipDeviceAttributeMultiprocessorCount, dev);
        if (hipFuncSetAttribute((const void*)mk_fwd, hipFuncAttributeMaxDynamicSharedMemorySize, LDS_BYTES) != hipSuccess) { fprintf(stderr, "kernel_launch: hipFuncSetAttribute failed\n"); grid = -1; return; }
        hipOccupancyMaxActiveBlocksPerMultiprocessor(&per_cu, (const void*)mk_fwd, NTHREADS, LDS_BYTES);
        if (per_cu < 1) { fprintf(stderr, "kernel_launch: occupancy query says %d blocks per CU\n", per_cu); grid = -1; return; }
        grid = cus;
    }
    if (grid < 0) return;
    (void)hipMemsetAsync((char*)d_ws + WS_CTL, 0, 16384, stream);
    Params p{};
    const float** pp = &p.x_prompt;
    for (int i = 0; i < 25; ++i) pp[i] = (const float*)d_in[i];
    p.out = (float*)d_out; p.ws = (unsigned char*)d_ws;
    for (int g = 0; g < 3; ++g) { const int dil = (g == 0) ? 1 : (g == 1 ? 4 : 16);
        for (int n = 0; n <= 128; ++n) { const int dist = n * dil; int bucket;
            if (dist < 16) bucket = dist; else { const int large = 16 + (int)(std::log((double)dist / 16.0) / std::log(2048.0 / 16.0) * 16.0); bucket = large < 31 ? large : 31; }
            p.tab.b[g][n] = (unsigned char)bucket; } }
#if MK_PER_PHASE
    for (int ph = 0; ph < N_PHASES; ++ph) { p.ph_lo = ph; p.ph_hi = ph + 1; hipLaunchKernelGGL(mk_fwd, dim3(grid), dim3(NTHREADS), LDS_BYTES, stream, p); }
#else
    p.ph_lo = 0; p.ph_hi = N_PHASES; p.rp = PROBE_RP; p.rc = PROBE_RC;
    void* args[] = {&p};
    hipError_t e = hipLaunchCooperativeKernel((const void*)mk_fwd, dim3(grid), dim3(NTHREADS), args, LDS_BYTES, stream);
    if (e != hipSuccess) fprintf(stderr, "kernel_launch: cooperative launch failed: %s\n", hipGetErrorString(e));
#endif
}
```

```cpp
#include <hip/hip_runtime.h>
#include <cstdint>
#include <cstdio>
#include <cmath>

#ifndef PROBE_RP
#define PROBE_RP 0
#define PROBE_RC 0
#endif
#ifndef MK_PER_PHASE
#define MK_PER_PHASE 0
#endif

#define LAS __attribute__((address_space(3)))
#define GAS __attribute__((address_space(1)))

namespace pg8 {
typedef unsigned short bf16_t;
typedef short bf16x8 __attribute__((ext_vector_type(8)));
typedef float f32x4 __attribute__((ext_vector_type(4)));
typedef unsigned u32x4 __attribute__((ext_vector_type(4)));
typedef unsigned u32x2 __attribute__((ext_vector_type(2)));
constexpr int BM = 256, BK = 64, HALF = 128, HTB = HALF * BK * 2, STAGE_BYTES = 8 * HTB, NXCD = 8, WGM = 8;

__host__ __device__ __forceinline__ int lds_byte(int r, int c) { const int st = (r >> 4) * 2 + (c >> 5), rr = r & 15, cc = c & 31, ob = rr * 64 + cc * 2; return st * 1024 + (ob ^ (((ob >> 9) & 1) << 5)); }
__host__ __device__ __forceinline__ void stage_rc(int b, int& R, int& C) { const int st = b / 1024, sb = b % 1024, swz = sb ^ (((sb >> 9) & 1) << 5); R = (st >> 1) * 16 + swz / 64; C = (st & 1) * 32 + (swz % 64) / 2; }
__host__ __device__ __forceinline__ int perm32(int rho) { const int n = rho >> 4, i = rho & 15; return 8 * (i >> 2) + 4 * n + (i & 3); }

struct Unit { int pm, pn, seg, nt; const char* a; const char* b; };
struct Gemm { const bf16_t* A; const bf16_t* Bt; int M, N, K, lda, ldb; };

__device__ __forceinline__ void tile_of(int wgid, int nM, int nN, int& pm, int& pn) {
    const int nwg = nM * nN; { const int q = nwg / NXCD, r = nwg % NXCD, xcd = wgid % NXCD, off = wgid / NXCD; wgid = (xcd < r ? xcd * (q + 1) : r * (q + 1) + (xcd - r) * q) + off; }
    const int nig = WGM * nN, gid = wgid / nig, fm = gid * WGM, gsz = (nM - fm) < WGM ? (nM - fm) : WGM;
    pm = fm + ((wgid % nig) % gsz); pn = (wgid % nig) / gsz;
}
struct StaticOrder {
    int nM, nN, nwg, G, c, nt; const char* A; const char* B; size_t tA, tB;
    __device__ void init(const Gemm& g, int G_, int c_) { nM = g.M / BM; nN = g.N / BM; nwg = nM * nN; G = G_; c = c_; nt = g.K / BK; A = (const char*)g.A; B = (const char*)g.Bt; tA = (size_t)BM * g.lda * 2; tB = (size_t)BM * g.ldb * 2; }
    __device__ bool next(int i, Unit& u) const {
        const long L = (long)i * G + c; if (L >= nwg) return false;
        tile_of((int)L, nM, nN, u.pm, u.pn); u.seg = 0; u.nt = nt; u.a = A + (size_t)u.pm * tA; u.b = B + (size_t)u.pn * tB; return true;
    }
};
struct SegOrder {
    int pm, pn; const char* A; const char* B; size_t tA, tB;
    __device__ void init(const Gemm& g, int c_) { tile_of(c_, g.M / BM, g.N / BM, pm, pn); A = (const char*)g.A; B = (const char*)g.Bt; tA = (size_t)BM * g.lda * 2; tB = (size_t)BM * g.ldb * 2; }
    __device__ bool next(int i, Unit& u) const {
        if (i >= 3) return false;
        u.pm = pm; u.pn = pn; u.seg = i; u.nt = (i == 2) ? 4 : 8; u.a = A + (size_t)pm * tA + (size_t)i * 1024; u.b = B + (size_t)pn * tB + (size_t)i * 1024; return true;
    }
};

__device__ __forceinline__ unsigned cvt_pk_bf16(float lo, float hi) { unsigned r; asm volatile("v_cvt_pk_bf16_f32 %0, %1, %2" : "=v"(r) : "v"(lo), "v"(hi)); return r; }
__device__ __forceinline__ float bf_lo(unsigned w) { return __uint_as_float(w << 16); }
__device__ __forceinline__ float bf_hi(unsigned w) { return __uint_as_float(w & 0xffff0000u); }

constexpr int EPI_LDS_OFF = 131072 + 2048;
struct EpiBf16 {
    static constexpr bool PERM = true, KEEP_ACC = false;
    bf16_t* O; int ldc; LAS unsigned char* lds;
    __device__ __forceinline__ void operator()(const f32x4 (&acc)[2][2][4][2], const Unit& u, int wr, int wc, int fr, int fq) const {
        LAS unsigned char* sc = lds + EPI_LDS_OFF + (wr * 4 + wc) * 1280;
        const int lane = fq * 16 + fr, lr = lane >> 2, ls = lane & 3;
        LAS u32x4* wp = (LAS u32x4*)(sc + fr * 80 + fq * 16);
        const LAS u32x4* rp = (const LAS u32x4*)(sc + lr * 80 + ls * 16);
        const int row0 = u.pm * BM + wr * 64 + lr, col0 = u.pn * BM + wc * 32 + 8 * ls;
#pragma unroll
        for (int ai = 0; ai < 2; ++ai)
#pragma unroll
            for (int m = 0; m < 4; ++m) { bf16_t* rowp = O + (size_t)(row0 + ai * HALF + m * 16) * ldc + col0;
#pragma unroll
                for (int bj = 0; bj < 2; ++bj) { const f32x4 v0 = acc[ai][bj][m][0], v1 = acc[ai][bj][m][1];
                    u32x4 w; w.x = cvt_pk_bf16(v0[0], v0[1]); w.y = cvt_pk_bf16(v0[2], v0[3]); w.z = cvt_pk_bf16(v1[0], v1[1]); w.w = cvt_pk_bf16(v1[2], v1[3]);
                    *wp = w; const u32x4 t = *rp;
                    *(u32x4*)(rowp + bj * HALF) = t; } }
    }
};
struct EpiF32 {
    static constexpr bool PERM = false, KEEP_ACC = false;
    float* C; int ldc;
    __device__ __forceinline__ void operator()(const f32x4 (&acc)[2][2][4][2], const Unit& u, int wr, int wc, int fr, int fq) const {
        const int row0 = u.pm * BM + wr * 64 + fr, col0 = u.pn * BM + wc * 32 + 4 * fq;
#pragma unroll
        for (int ai = 0; ai < 2; ++ai)
#pragma unroll
            for (int m = 0; m < 4; ++m) { float* rowp = C + (size_t)(row0 + ai * HALF + m * 16) * ldc + col0;
#pragma unroll
                for (int bj = 0; bj < 2; ++bj)
#pragma unroll
                    for (int n = 0; n < 2; ++n) *(f32x4*)(rowp + bj * HALF + n * 16) = acc[ai][bj][m][n]; }
    }
};
struct EpiGate {
    static constexpr bool PERM = true, KEEP_ACC = true;
    const bf16_t* gl0; int ldg; bf16_t* MG;
    __device__ __forceinline__ void operator()(f32x4 (&acc)[2][2][4][2], const Unit& u, int wr, int wc, int fr, int fq) const {
        const int row0 = u.pm * BM + wr * 64 + fr, col0 = u.pn * BM + wc * 32 + 8 * fq, seg = u.seg;
        const bf16_t* gn = gl0 + 2048 * seg;
        const bf16_t* gd = gl0 + 2048 * (seg < 2 ? seg + 1 : seg);
#pragma unroll
        for (int ai = 0; ai < 2; ++ai) {
            u32x4 gw[4][2], hw[4][2];
#pragma unroll
            for (int m = 0; m < 4; ++m)
#pragma unroll
                for (int bj = 0; bj < 2; ++bj) { const size_t o = (size_t)(row0 + ai * HALF + m * 16) * ldg + col0 + bj * HALF;
                    gw[m][bj] = *(const u32x4*)(gn + o); hw[m][bj] = *(const u32x4*)(gd + o); }
#pragma unroll
            for (int m = 0; m < 4; ++m)
#pragma unroll
                for (int bj = 0; bj < 2; ++bj) { const int r = row0 + ai * HALF + m * 16, c = col0 + bj * HALF;
                    const u32x4 g4 = gw[m][bj], h4 = hw[m][bj];
                    float g[8], h[8];
                    g[0] = bf_lo(g4.x); g[1] = bf_hi(g4.x); g[2] = bf_lo(g4.y); g[3] = bf_hi(g4.y); g[4] = bf_lo(g4.z); g[5] = bf_hi(g4.z); g[6] = bf_lo(g4.w); g[7] = bf_hi(g4.w);
                    h[0] = bf_lo(h4.x); h[1] = bf_hi(h4.x); h[2] = bf_lo(h4.y); h[3] = bf_hi(h4.y); h[4] = bf_lo(h4.z); h[5] = bf_hi(h4.z); h[6] = bf_lo(h4.w); h[7] = bf_hi(h4.w);
                    float v[8];
#pragma unroll
                    for (int j = 0; j < 8; ++j) { const float num = (seg < 2) ? (1.0f + __expf(-h[j])) : 1.0f;
                        v[j] = acc[ai][bj][m][j >> 2][j & 3] * num * __builtin_amdgcn_rcpf(1.0f + __expf(-g[j])); acc[ai][bj][m][j >> 2][j & 3] = v[j]; }
                    if (seg == 2) { u32x4 w; w.x = cvt_pk_bf16(v[0], v[1]); w.y = cvt_pk_bf16(v[2], v[3]); w.z = cvt_pk_bf16(v[4], v[5]); w.w = cvt_pk_bf16(v[6], v[7]);
                        *(u32x4*)(MG + (size_t)r * 2048 + c) = w; } }
        }
    }
};

template <class Epi, bool ALIGN_EPI, class Sched>
__device__ __forceinline__ void gemm_phase(LAS unsigned char* lds, const int tid, const Gemm g, const Sched& S, const Epi& E) {
    const int wid = __builtin_amdgcn_readfirstlane(tid >> 6), lane = tid & 63, wr = wid >> 2, wc = wid & 3, fr = lane & 15, fq = lane >> 4;
    unsigned voffA[2], voffB[2];
#pragma unroll
    for (int i = 0; i < 2; ++i) { int R, C; stage_rc(tid * 16 + i * 8192, R, C); const int Rb = Epi::PERM ? ((R & ~31) + perm32(R & 31)) : R;
        voffA[i] = (unsigned)(R * g.lda + C) * 2u; voffB[i] = (unsigned)(Rb * g.ldb + C) * 2u; }
    const size_t kstep = (size_t)(BK * 2);
    const size_t hstepA = (size_t)HALF * g.lda * 2, hstepB = (size_t)HALF * g.ldb * 2;
    const unsigned ldsw = (unsigned)wid * 1024u;
    const int aoff = lds_byte(wr * 64 + fr, fq * 8), boff = lds_byte(wc * 32 + fr, fq * 8);
#define PG8_SA(b, h) (((b) * 2 + (h)) * HTB)
#define PG8_SB(b, h) ((4 + (b) * 2 + (h)) * HTB)
#define PG8_STAGE(bufoff, gbase, voff) do { _Pragma("unroll") for (int _i = 0; _i < 2; ++_i) \
        __builtin_amdgcn_global_load_lds((const unsigned*)((const char*)(gbase) + (voff)[_i]), (LAS unsigned*)(lds + (bufoff) + ldsw + _i * 8192), 16, 0, 0); } while (0)
#define PG8_LDA(dst, b, h) do { _Pragma("unroll") for (int m = 0; m < 4; ++m) _Pragma("unroll") for (int k = 0; k < 2; ++k) dst[m][k] = *(const LAS bf16x8*)(lds + PG8_SA(b, h) + aoff + m * 2048 + k * 1024); } while (0)
#define PG8_LDB(dst, b, h) do { _Pragma("unroll") for (int n = 0; n < 2; ++n) _Pragma("unroll") for (int k = 0; k < 2; ++k) dst[n][k] = *(const LAS bf16x8*)(lds + PG8_SB(b, h) + boff + n * 2048 + k * 1024); } while (0)
#define PG8_MMA(ai, bj, At, Bt) do { __builtin_amdgcn_s_setprio(1); _Pragma("unroll") for (int m = 0; m < 4; ++m) _Pragma("unroll") for (int n = 0; n < 2; ++n) _Pragma("unroll") for (int k = 0; k < 2; ++k) \
        acc[ai][bj][m][n] = __builtin_amdgcn_mfma_f32_16x16x32_bf16(Bt[n][k], At[m][k], acc[ai][bj][m][n], 0, 0, 0); __builtin_amdgcn_s_setprio(0); } while (0)
#define PG8_WAIT_V(n) asm volatile("s_waitcnt vmcnt(" #n ")" ::: "memory")
#define PG8_WAIT_L(n) asm volatile("s_waitcnt lgkmcnt(" #n ")" ::: "memory")
#define PG8_BAR __builtin_amdgcn_s_barrier()
#define PG8_SCHED __builtin_amdgcn_sched_barrier(0)
    Unit cur, nxt; int ui = 0;
    if (!S.next(0, cur)) return;
    f32x4 acc[2][2][4][2];
#pragma unroll
    for (int a = 0; a < 2; ++a)
#pragma unroll
        for (int b = 0; b < 2; ++b)
#pragma unroll
            for (int m = 0; m < 4; ++m)
#pragma unroll
                for (int n = 0; n < 2; ++n) acc[a][b][m][n] = (f32x4){0.f, 0.f, 0.f, 0.f};
    bf16x8 At[4][2], B0[2][2], B1[2][2];
    const char* cA = cur.a; const char* cB = cur.b;
    PG8_STAGE(PG8_SB(0, 0), cB, voffB); PG8_STAGE(PG8_SB(0, 1), cB + hstepB, voffB); PG8_STAGE(PG8_SA(0, 0), cA, voffA); PG8_STAGE(PG8_SA(0, 1), cA + hstepA, voffA);
    if (wr == 1) PG8_BAR;
    PG8_WAIT_V(2); PG8_BAR;
    PG8_STAGE(PG8_SB(1, 0), cB + kstep, voffB); PG8_STAGE(PG8_SA(1, 0), cA + kstep, voffA); PG8_STAGE(PG8_SB(1, 1), cB + hstepB + kstep, voffB);
    PG8_WAIT_V(6); PG8_BAR;
    for (;;) {
        const bool has_next = S.next(ui + 1, nxt);
        const char* nA = has_next ? nxt.a : cA; const char* nB = has_next ? nxt.b : cB;
        const int nt = cur.nt;
        for (int t = 0; t < nt; t += 2) {
            const bool last = (t == nt - 2);
            const char* a1 = cA + (size_t)(t + 1) * kstep;
            const char* a2 = last ? nA : cA + (size_t)(t + 2) * kstep; const char* b2 = last ? nB : cB + (size_t)(t + 2) * kstep;
            const char* a3 = a2 + kstep; const char* b3 = b2 + kstep;
            PG8_LDB(B0, 0, 0); PG8_LDB(B1, 0, 1); PG8_SCHED; PG8_LDA(At, 0, 0); PG8_STAGE(PG8_SA(1, 1), a1 + hstepA, voffA);
            PG8_WAIT_V(8); PG8_WAIT_L(0); PG8_BAR; PG8_MMA(0, 0, At, B0); PG8_MMA(0, 1, At, B1); PG8_BAR; PG8_SCHED;
            PG8_LDA(At, 0, 1); PG8_STAGE(PG8_SB(0, 0), b2, voffB); PG8_STAGE(PG8_SB(0, 1), b2 + hstepB, voffB); PG8_STAGE(PG8_SA(0, 0), a2, voffA);
            PG8_WAIT_V(8); PG8_WAIT_L(0); PG8_BAR; PG8_MMA(1, 0, At, B0); PG8_MMA(1, 1, At, B1); PG8_BAR; PG8_SCHED;
            PG8_LDB(B0, 1, 0); PG8_LDB(B1, 1, 1); PG8_SCHED; PG8_LDA(At, 1, 0); PG8_STAGE(PG8_SA(0, 1), a2 + hstepA, voffA);
            PG8_WAIT_V(8); PG8_WAIT_L(0); PG8_BAR; PG8_MMA(0, 0, At, B0); PG8_MMA(0, 1, At, B1); PG8_BAR; PG8_SCHED;
            PG8_LDA(At, 1, 1); PG8_STAGE(PG8_SB(1, 0), b3, voffB); PG8_STAGE(PG8_SB(1, 1), b3 + hstepB, voffB); PG8_STAGE(PG8_SA(1, 0), a3, voffA);
            PG8_WAIT_V(8); PG8_WAIT_L(0); PG8_BAR; PG8_MMA(1, 0, At, B0); PG8_MMA(1, 1, At, B1); PG8_BAR; PG8_SCHED;
        }
        if constexpr (ALIGN_EPI) { if (wr == 0) PG8_BAR; }
        E(acc, cur, wr, wc, fr, fq);
        if (!has_next) break;
        if constexpr (!Epi::KEEP_ACC) {
#pragma unroll
        for (int a = 0; a < 2; ++a)
#pragma unroll
            for (int b = 0; b < 2; ++b)
#pragma unroll
                for (int m = 0; m < 4; ++m)
#pragma unroll
                    for (int n = 0; n < 2; ++n) acc[a][b][m][n] = (f32x4){0.f, 0.f, 0.f, 0.f};
        }
        cur = nxt; cA = nA; cB = nB; ++ui;
        if constexpr (ALIGN_EPI) { if (wr == 1) PG8_BAR; }
    }
    PG8_WAIT_V(0);
    if constexpr (!ALIGN_EPI) { if (wr == 0) PG8_BAR; }
    PG8_BAR;
#undef PG8_SA
#undef PG8_SB
#undef PG8_STAGE
#undef PG8_LDA
#undef PG8_LDB
#undef PG8_MMA
#undef PG8_WAIT_V
#undef PG8_WAIT_L
#undef PG8_BAR
#undef PG8_SCHED
}
}

typedef unsigned short bf16;
typedef unsigned v4u __attribute__((ext_vector_type(4)));
typedef unsigned v2u __attribute__((ext_vector_type(2)));
typedef float f32x4 __attribute__((ext_vector_type(4)));

constexpr int D_MODEL = 2048, BATCH = 2, SEQ = 4096, DEPTH = 2, DEC_BATCH = 8;
constexpr int MP = BATCH * SEQ, MT = MP + DEC_BATCH, NB = BATCH + DEC_BATCH;
constexpr int N_IN = 10496, D_FF = 5632, N_UP = 2 * D_FF, N_MOD = 6, K_BR = 1280;
constexpr int OFF_Q = 0, OFF_K = 768, OFF_V = 1536, OFF_P = 2304, OFF_GB = 2816, OFF_GC = 3328, OFF_HC = 3840, OFF_GL = 4352;
constexpr float EPS = 1e-6f;
constexpr int NWAVES = 8, NTHREADS = 512;
constexpr int LDS_BYTES = 147456;

constexpr size_t al256(size_t x) { return (x + 255) & ~(size_t)255; }
constexpr size_t WS_CTL = 0, CTL_BYTES = 1u << 20;
constexpr size_t SZ_WTIN = (size_t)N_IN * D_MODEL * 2, SZ_WTBR = (size_t)D_MODEL * K_BR * 2, SZ_WTO = (size_t)D_MODEL * D_MODEL * 2, SZ_WTUP = (size_t)N_UP * D_MODEL * 2, SZ_WTDN = (size_t)D_MODEL * D_FF * 2;
constexpr size_t WS_WTIN = WS_CTL + CTL_BYTES;
constexpr size_t WS_WTBR = WS_WTIN + DEPTH * SZ_WTIN;
constexpr size_t WS_WTO = WS_WTBR + DEPTH * SZ_WTBR;
constexpr size_t WS_WTUP = WS_WTO + DEPTH * SZ_WTO;
constexpr size_t WS_WTDN = WS_WTUP + DEPTH * SZ_WTUP;
constexpr size_t WS_MOD = WS_WTDN + DEPTH * SZ_WTDN;
constexpr size_t WS_BIAS = WS_MOD + al256((size_t)DEPTH * NB * N_MOD * D_MODEL * 4);
constexpr size_t WS_H = WS_BIAS + 8192;
constexpr size_t WS_Y = WS_H + al256((size_t)MT * D_MODEL * 2);
constexpr size_t WS_A2 = WS_Y + al256((size_t)MT * N_UP * 2);
constexpr size_t WS_T = WS_A2 + al256((size_t)MT * K_BR * 2);
constexpr size_t WS_MG = WS_T + al256((size_t)MT * D_MODEL * 4);
constexpr size_t WS_ACT = WS_MG + al256((size_t)MT * D_MODEL * 2);
constexpr size_t WS_XS = WS_ACT + al256((size_t)MT * D_FF * 2);
constexpr size_t WS_OG = WS_XS + al256((size_t)DEC_BATCH * D_MODEL * 4);
constexpr size_t WS_LSE = WS_OG + al256((size_t)MT * 768 * 2);
constexpr size_t WS_XB = WS_LSE + al256((size_t)MT * 12 * 4);
constexpr size_t WS_PM = WS_XB + al256((size_t)MP * D_MODEL * 2);
constexpr size_t WS_END = WS_PM + al256((size_t)8 * DEPTH * NB * N_MOD * D_MODEL * 4);

struct BucketTab { unsigned char b[3][132]; unsigned pad; };
struct Params {
    const float *x_prompt, *x_sample, *c_prompt, *c_sample, *c128, *c512, *c2048, *state_pool, *state_conv, *state_ffn, *rel_bias, *norm_g, *w_ada, *b_ada, *w_in,
        *w_attn_br, *w_pool_grp, *pool_scale, *w_pool_br, *conv_w, *w_conv_br, *w_o, *w_up, *ffn_conv_w, *w_down;
    float* out; unsigned char* ws;
    BucketTab tab;
    int ph_lo, ph_hi, rp, rc;
};

constexpr int PARAM_LDS_OFF = 131072 + 1024;
struct PL {
    LAS const unsigned char* b;
    __device__ __forceinline__ const float* ldp(int off) const { const LAS unsigned* q = (const LAS unsigned*)(b + off);
        const unsigned lo = __builtin_amdgcn_readfirstlane(q[0]), hi = __builtin_amdgcn_readfirstlane(q[1]); return (const float*)(const GAS float*)(((unsigned long long)hi << 32) | lo); }
#define PL_F(name) __device__ __forceinline__ const float* name() const { return ldp((int)offsetof(Params, name)); }
    PL_F(x_prompt)
    PL_F(x_sample)
    PL_F(c_prompt)
    PL_F(c_sample)
    PL_F(c128)
    PL_F(c512)
    PL_F(c2048)
    PL_F(state_pool)
    PL_F(state_conv)
    PL_F(state_ffn)
    PL_F(rel_bias)
    PL_F(norm_g)
    PL_F(w_ada)
    PL_F(b_ada)
    PL_F(w_in)
    PL_F(w_attn_br)
    PL_F(w_pool_grp)
    PL_F(pool_scale)
    PL_F(w_pool_br)
    PL_F(conv_w)
    PL_F(w_conv_br)
    PL_F(w_o)
    PL_F(w_up)
    PL_F(ffn_conv_w)
    PL_F(w_down)
#undef PL_F
    __device__ __forceinline__ int bucket(int g, int n) const { return (int)b[(int)offsetof(Params, tab) + g * 132 + n]; }
};
constexpr size_t O_YP = 0, O_YS = O_YP + (size_t)MP * D_MODEL;
constexpr size_t O_KVP0 = O_YS + (size_t)DEC_BATCH * D_MODEL;
constexpr size_t O_KVP1 = O_KVP0 + (size_t)DEPTH * BATCH * 128 * 512;
constexpr size_t O_KVP2 = O_KVP1 + (size_t)DEPTH * BATCH * 512 * 512;
constexpr size_t O_POOLP = O_KVP2 + (size_t)DEPTH * BATCH * 2048 * 512;
constexpr size_t O_CONVP = O_POOLP + (size_t)DEPTH * BATCH * 15 * 512;
constexpr size_t O_FFNP = O_CONVP + (size_t)DEPTH * BATCH * 2 * 512;
constexpr size_t O_KVS0 = O_FFNP + (size_t)DEPTH * BATCH * 2 * N_UP;
constexpr size_t O_KVS1 = O_KVS0 + (size_t)DEPTH * DEC_BATCH * 512;
constexpr size_t O_KVS2 = O_KVS1 + (size_t)DEPTH * DEC_BATCH * 512;
constexpr size_t O_POOLS = O_KVS2 + (size_t)DEPTH * DEC_BATCH * 512;
constexpr size_t O_CONVS = O_POOLS + (size_t)DEPTH * DEC_BATCH * 15 * 512;
constexpr size_t O_FFNS = O_CONVS + (size_t)DEPTH * DEC_BATCH * 2 * 512;
constexpr size_t O_END = O_FFNS + (size_t)DEPTH * DEC_BATCH * 2 * N_UP;

__device__ __forceinline__ float bf2f(bf16 v) { return __uint_as_float((unsigned)v << 16); }
__device__ __forceinline__ unsigned f2bf(float f) { unsigned u = __float_as_uint(f); return (u + 0x7fffu + ((u >> 16) & 1u)) >> 16; }
__device__ __forceinline__ unsigned pk2(float lo, float hi) { return pg8::cvt_pk_bf16(lo, hi); }
__device__ __forceinline__ float blo(unsigned w) { return __uint_as_float(w << 16); }
__device__ __forceinline__ float bhi(unsigned w) { return __uint_as_float(w & 0xffff0000u); }
__device__ __forceinline__ void unpack8(const v4u w, float (&f)[8]) { f[0] = blo(w.x); f[1] = bhi(w.x); f[2] = blo(w.y); f[3] = bhi(w.y); f[4] = blo(w.z); f[5] = bhi(w.z); f[6] = blo(w.w); f[7] = bhi(w.w); }
__device__ __forceinline__ v4u pack8(const float (&f)[8]) { v4u w; w.x = pk2(f[0], f[1]); w.y = pk2(f[2], f[3]); w.z = pk2(f[4], f[5]); w.w = pk2(f[6], f[7]); return w; }
typedef __bf16 bf16x2_t __attribute__((ext_vector_type(2)));
__device__ __forceinline__ float dot2bf(unsigned a, unsigned b, float acc) { return __builtin_amdgcn_fdot2_f32_bf16(__builtin_bit_cast(bf16x2_t, a), __builtin_bit_cast(bf16x2_t, b), acc, false); }
__device__ __forceinline__ float dot8(const v4u a, const v4u b, float acc) { acc = dot2bf(a.x, b.x, acc); acc = dot2bf(a.y, b.y, acc); acc = dot2bf(a.z, b.z, acc); return dot2bf(a.w, b.w, acc); }
__device__ __forceinline__ float wave_sum(float v) {
#pragma unroll
    for (int o = 1; o < 64; o <<= 1) v += __shfl_xor(v, o);
    return v; }
__device__ __forceinline__ float wave_max(float v) {
#pragma unroll
    for (int o = 1; o < 64; o <<= 1) v = fmaxf(v, __shfl_xor(v, o));
    return v; }
#define LDS_FENCE() asm volatile("s_waitcnt lgkmcnt(0)" ::: "memory")
__device__ __forceinline__ float reduce8(const float (&a)[8], int lane) {
    float b[4], c2[2], d;
    const bool h32 = (lane & 32) != 0, h16 = (lane & 16) != 0, h8 = (lane & 8) != 0;
#pragma unroll
    for (int i = 0; i < 4; ++i) { const float snd = h32 ? a[i] : a[i + 4], kep = h32 ? a[i + 4] : a[i]; b[i] = kep + __shfl_xor(snd, 32); }
#pragma unroll
    for (int i = 0; i < 2; ++i) { const float snd = h16 ? b[i] : b[i + 2], kep = h16 ? b[i + 2] : b[i]; c2[i] = kep + __shfl_xor(snd, 16); }
    { const float snd = h8 ? c2[0] : c2[1], kep = h8 ? c2[1] : c2[0]; d = kep + __shfl_xor(snd, 8); }
    d += __shfl_xor(d, 4); d += __shfl_xor(d, 2); d += __shfl_xor(d, 1);
    return d;
}
__device__ __forceinline__ float sigmoidf_(float x) { float e = __expf(-x); asm volatile("" : "+v"(e)); return __builtin_amdgcn_rcpf(1.0f + e); }
__device__ __forceinline__ float gelu_tanh(float x) {
    const float z = x * fmaf(-0.1029432396f, x * x, -2.3022081981f);
    return x * __builtin_amdgcn_rcpf(1.0f + __builtin_amdgcn_exp2f(z)); }

__device__ __forceinline__ int up_perm(int n) { return n < D_FF ? 256 * (n >> 7) + (n & 127) : 256 * ((n - D_FF) >> 7) + 128 + ((n - D_FF) & 127); }
__device__ __forceinline__ int up_unperm(int r) { return ((r >> 7) & 1) * D_FF + 128 * (r >> 8) + (r & 127); }
template <int N> __device__ __forceinline__ float dpp_ror(float x) { return __int_as_float(__builtin_amdgcn_mov_dpp(__float_as_int(x), 0x120 + N, 0xf, 0xf, false)); }
struct EpiFfn {
    static constexpr bool PERM = true, KEEP_ACC = false;
    bf16* ACT; bf16* UP; const float* fw;
    __device__ __forceinline__ void operator()(const f32x4 (&acc)[2][2][4][2], const pg8::Unit& u, int wr, int wc, int fr, int fq) const {
        const int row0 = u.pm * 256 + wr * 64 + fr, j0 = u.pn * 128 + wc * 32 + 8 * fq;
        v2u keep[2][4];
        f32x4 wga[2][3], wva[2][3];
#pragma unroll
        for (int n = 0; n < 2; ++n)
#pragma unroll
            for (int t = 0; t < 3; ++t) { wga[n][t] = *(const f32x4*)(fw + (size_t)t * N_UP + j0 + 4 * n); wva[n][t] = *(const f32x4*)(fw + (size_t)t * N_UP + D_FF + j0 + 4 * n); }
#pragma unroll
        for (int n = 0; n < 2; ++n) {
            const int j = j0 + 4 * n;
            f32x4 wg[3], wv[3];
#pragma unroll
            for (int t = 0; t < 3; ++t) { wg[t] = wga[n][t]; wv[t] = wva[n][t]; }
#pragma unroll
            for (int ai = 0; ai < 2; ++ai) {
                f32x4 g1p = (f32x4){0.f, 0.f, 0.f, 0.f}, g2p = g1p, v1p = g1p, v2p = g1p;
#pragma unroll
                for (int m = 0; m < 4; ++m) {
                    const f32x4 g = acc[ai][0][m][n], v = acc[ai][1][m][n];
                    f32x4 g1, g2, v1, v2, o;
#pragma unroll
                    for (int e = 0; e < 4; ++e) { g1[e] = dpp_ror<1>(g[e]); g2[e] = dpp_ror<2>(g[e]); v1[e] = dpp_ror<1>(v[e]); v2[e] = dpp_ror<2>(v[e]); }
                    {
                        const f32x4 pg1 = fr >= 1 ? g1 : g1p, pg2 = fr >= 2 ? g2 : g2p, pv1 = fr >= 1 ? v1 : v1p, pv2 = fr >= 2 ? v2 : v2p;
                        const f32x4 cg = wg[2] * g + wg[1] * pg1 + wg[0] * pg2, cv = wv[2] * v + wv[1] * pv1 + wv[0] * pv2;
                        const f32x4 z = cg * (cg * cg * (-0.1029432396f) + (-2.3022081981f));
                        f32x4 d;
#pragma unroll
                        for (int e = 0; e < 4; ++e) d[e] = __builtin_amdgcn_exp2f(z[e]);
                        d = d + 1.0f;
#pragma unroll
                        for (int e = 0; e < 4; ++e) d[e] = __builtin_amdgcn_rcpf(d[e]);
                        o = cg * d * cv; }
                    const int r = row0 + 128 * ai + 16 * m;
                    v2u pk; pk.x = pg8::cvt_pk_bf16(o[0], o[1]); pk.y = pg8::cvt_pk_bf16(o[2], o[3]);
                    if (n == 0) keep[ai][m] = pk;
                    else if (!(m == 0 && fr < 2)) { v4u w; w.x = keep[ai][m].x; w.y = keep[ai][m].y; w.z = pk.x; w.w = pk.y; *(v4u*)(ACT + (size_t)r * D_FF + j0) = w; }
                    if ((m == 0 && fr < 2) || (m == 3 && fr >= 14)) {
                        v2u rg, rv; rg.x = pg8::cvt_pk_bf16(g[0], g[1]); rg.y = pg8::cvt_pk_bf16(g[2], g[3]); rv.x = pg8::cvt_pk_bf16(v[0], v[1]); rv.y = pg8::cvt_pk_bf16(v[2], v[3]);
                        *(v2u*)(UP + (size_t)r * N_UP + j) = rg; *(v2u*)(UP + (size_t)r * N_UP + D_FF + j) = rv; }
                    g1p = g1; g2p = g2; v1p = v1; v2p = v2;
                }
            }
        }
    }
};
struct StBf16Up { bf16* O; __device__ __forceinline__ void operator()(int n, int r, float v) const { O[(size_t)r * N_UP + up_unperm(n)] = (bf16)f2bf(v); } };

struct Ctx {
    LAS unsigned char* lds; int tid, lane, wave, gw, NGW, bid, G;
};
struct StBf16 { bf16* O; int ld; __device__ __forceinline__ void operator()(int n, int r, float v) const { O[(size_t)r * ld + n] = (bf16)f2bf(v); } };
struct StF32 { float* O; int ld; __device__ __forceinline__ void operator()(int n, int r, float v) const { O[(size_t)r * ld + n] = v; } };

struct TItem { const float* src; bf16* dst; int N, ldt; };
__device__ __forceinline__ TItem titem_desc(const PL p, unsigned char* ws, int it) {
    constexpr int I_IN = (D_MODEL / 64) * (N_IN / 32), I_O = (D_MODEL / 64) * (D_MODEL / 32), I_UP = (D_MODEL / 64) * (N_UP / 32), I_DN = (D_FF / 64) * (D_MODEL / 32),
                  I_CV = (512 / 64) * (D_MODEL / 32), I_AT = (256 / 64) * (D_MODEL / 32), I_L = I_IN + I_O + I_UP + I_DN + I_CV + I_AT;
    const int l = it / I_L; int r = it % I_L;
    const float* W; bf16* WT; int N, ldt, koff = 0, k0, n0;
    if (r < I_IN) { W = p.w_in() + (size_t)l * D_MODEL * N_IN; N = N_IN; WT = (bf16*)(ws + WS_WTIN + l * SZ_WTIN); ldt = D_MODEL; k0 = 64 * (r / (N_IN / 32)); n0 = 32 * (r % (N_IN / 32)); }
    else if ((r -= I_IN) < I_O) { W = p.w_o() + (size_t)l * D_MODEL * D_MODEL; N = D_MODEL; WT = (bf16*)(ws + WS_WTO + l * SZ_WTO); ldt = D_MODEL; k0 = 64 * (r / (D_MODEL / 32)); n0 = 32 * (r % (D_MODEL / 32)); }
    else if ((r -= I_O) < I_UP) { W = p.w_up() + (size_t)l * D_MODEL * N_UP; N = N_UP; WT = (bf16*)(ws + WS_WTUP + l * SZ_WTUP); ldt = D_MODEL; k0 = 64 * (r / (N_UP / 32)); n0 = 32 * (r % (N_UP / 32)); }
    else if ((r -= I_UP) < I_DN) { W = p.w_down() + (size_t)l * D_FF * D_MODEL; N = D_MODEL; WT = (bf16*)(ws + WS_WTDN + l * SZ_WTDN); ldt = D_FF; k0 = 64 * (r / (D_MODEL / 32)); n0 = 32 * (r % (D_MODEL / 32)); }
    else if ((r -= I_DN) < I_CV) { W = p.w_conv_br() + (size_t)l * 512 * D_MODEL; N = D_MODEL; WT = (bf16*)(ws + WS_WTBR + l * SZ_WTBR); ldt = K_BR; koff = 512; k0 = 64 * (r / (D_MODEL / 32)); n0 = 32 * (r % (D_MODEL / 32)); }
    else { r -= I_CV; W = p.w_attn_br() + (size_t)l * 256 * D_MODEL; N = D_MODEL; WT = (bf16*)(ws + WS_WTBR + l * SZ_WTBR); ldt = K_BR; koff = 1024; k0 = 64 * (r / (D_MODEL / 32)); n0 = 32 * (r % (D_MODEL / 32)); }
    const int nrow = (N == N_UP) ? up_perm(n0) : n0;
    TItem t; t.src = W + (size_t)k0 * N + n0; t.dst = WT + (size_t)nrow * ldt + koff + k0; t.N = N; t.ldt = ldt; return t;
}
constexpr int N_TITEMS = DEPTH * ((D_MODEL / 64) * (N_IN / 32) + (D_MODEL / 64) * (D_MODEL / 32) + (D_MODEL / 64) * (N_UP / 32) + (D_FF / 64) * (D_MODEL / 32) + (512 / 64) * (D_MODEL / 32) + (256 / 64) * (D_MODEL / 32));
__device__ __forceinline__ void titem_load(const TItem& t, int lane, f32x4 (&v)[8]) {
    const float* s = t.src + (size_t)(8 * (lane >> 3)) * t.N + 4 * (lane & 7);
#pragma unroll
    for (int j = 0; j < 8; ++j) v[j] = __builtin_nontemporal_load((const f32x4*)(s + (size_t)j * t.N));
}
__device__ __forceinline__ void titem_store(const TItem& t, int lane, const f32x4 (&v)[8]) {
    bf16* d = t.dst + (size_t)(4 * (lane & 7)) * t.ldt + 8 * (lane >> 3);
#pragma unroll
    for (int e = 0; e < 4; ++e) { v4u o; o.x = pk2(v[0][e], v[1][e]); o.y = pk2(v[2][e], v[3][e]); o.z = pk2(v[4][e], v[5][e]); o.w = pk2(v[6][e], v[7][e]);
        *(v4u*)(d + (size_t)e * t.ldt) = o; }
}

__device__ __forceinline__ void phase_A(const PL p, const Ctx& c, unsigned char* ws) {
    { LAS float* scs = (LAS float*)c.lds;
      LAS float* red = (LAS float*)(c.lds + 10240);
      float* PM = (float*)(ws + WS_PM);
      for (int item = c.bid; item < DEPTH * 48 * 8; item += c.G) {
        const int layer = item / 384, ksl = (item % 384) / 48, cg = item % 48, c4 = c.lane & 7, ks = c.lane >> 3, k0 = ksl * 256;
        __syncthreads();
        for (int i = c.tid; i < NB * 256; i += NTHREADS) { const int b = i >> 8, k = k0 + (i & 255);
            const float v = (b < BATCH) ? p.c_prompt()[b * D_MODEL + k] : p.c_sample()[(b - BATCH) * D_MODEL + k]; scs[i] = v / (1.0f + __expf(-v)); }
        __syncthreads();
        const float* W = p.w_ada() + (size_t)layer * D_MODEL * (N_MOD * D_MODEL) + (size_t)(k0 + ks) * (N_MOD * D_MODEL) + cg * 256 + c.wave * 32 + 4 * c4;
        f32x4 acc[NB];
#pragma unroll
        for (int b = 0; b < NB; ++b) acc[b] = (f32x4){0.f, 0.f, 0.f, 0.f};
        for (int i0 = 0; i0 < 32; i0 += 8) {
            f32x4 w[8];
#pragma unroll
            for (int i = 0; i < 8; ++i) w[i] = __builtin_nontemporal_load((const f32x4*)(W + (size_t)((i0 + i) * 8) * (N_MOD * D_MODEL)));
#pragma unroll
            for (int i = 0; i < 8; ++i) { const int kk = (i0 + i) * 8 + ks;
#pragma unroll
                for (int b = 0; b < NB; ++b) acc[b] = acc[b] + w[i] * scs[b * 256 + kk]; }
        }
#pragma unroll
        for (int b = 0; b < NB; ++b) *(LAS f32x4*)(red + ((c.wave * 8 + ks) * NB + b) * 32 + 4 * c4) = acc[b];
        __syncthreads();
        for (int i = c.tid; i < NB * 256; i += NTHREADS) { const int b = i >> 8, col = i & 255, w = col >> 5, cc = col & 31; float sm = 0.f;
#pragma unroll
            for (int k8 = 0; k8 < 8; ++k8) sm += red[((w * 8 + k8) * NB + b) * 32 + cc];
            PM[((size_t)(ksl * DEPTH + layer) * NB + b) * (N_MOD * D_MODEL) + cg * 256 + col] = sm; }
      }
      __syncthreads(); }
    for (int it = c.gw; it < N_TITEMS; it += c.NGW) {
        const TItem t0 = titem_desc(p, ws, it);
        f32x4 v0[8];
        titem_load(t0, c.lane, v0);
        titem_store(t0, c.lane, v0);
    }
    for (int it = c.gw; it < DEPTH * 2048; it += c.NGW) {
        const int l = it / 2048, kc = (it % 2048) / 32, nb = it % 32, k0 = kc * 8, g = k0 >> 7, c0 = k0 & 127, n = nb * 64 + c.lane;
        const float* wpg = p.w_pool_grp() + (size_t)l * 4 * 128 * 128 + (size_t)(g * 128 + c0) * 128;
        const float* ps = p.pool_scale() + (size_t)l * 512 + g * 128;
        const float* wpb = p.w_pool_br() + (size_t)l * 512 * D_MODEL + (size_t)(g * 128) * D_MODEL + n;
        float acc[8];
#pragma unroll
        for (int j = 0; j < 8; ++j) acc[j] = 0.f;
        for (int e0 = 0; e0 < 128; e0 += 16) {
            float wb[16];
#pragma unroll
            for (int u = 0; u < 16; ++u) wb[u] = wpb[(size_t)(e0 + u) * D_MODEL];
#pragma unroll
            for (int u = 0; u < 16; ++u) { const float w = wb[u] * ps[e0 + u];
#pragma unroll
                for (int j = 0; j < 8; ++j) acc[j] = fmaf(wpg[j * 128 + e0 + u], w, acc[j]); }
        }
        *(v4u*)((bf16*)(ws + WS_WTBR + l * SZ_WTBR) + (size_t)n * K_BR + k0) = pack8(acc);
    }
    if (c.bid == 0) { float* biasT = (float*)(ws + WS_BIAS);
        for (int i = c.tid; i < 3 * 4 * 129; i += NTHREADS) { const int g = i / (4 * 129), h = (i / 129) % 4, n = i % 129; biasT[i] = p.rel_bias()[p.bucket(g, n) * 12 + g * 4 + h]; } }
}

__device__ __forceinline__ void modsum_phase(const PL p, const Ctx& c, unsigned char* ws) {
    const float* PM = (const float*)(ws + WS_PM); float* mod = (float*)(ws + WS_MOD);
    constexpr int NTOT = DEPTH * NB * N_MOD * D_MODEL;
    for (int i = c.gw * 64 + c.lane; i < NTOT; i += c.NGW * 64) {
        float v[8];
#pragma unroll
        for (int s8 = 0; s8 < 8; ++s8) v[s8] = PM[(size_t)s8 * NTOT + i];
        const int layer = i / (NB * N_MOD * D_MODEL), col = i % (N_MOD * D_MODEL);
        mod[i] = ((v[0] + v[1]) + (v[2] + v[3])) + ((v[4] + v[5]) + (v[6] + v[7])) + p.b_ada()[(size_t)layer * (N_MOD * D_MODEL) + col]; }
}

__device__ __forceinline__ void rownorm_phase(const Ctx& c, const float* xin_p, const bf16* xin_pb, const float* xin_s, const bf16* y, const float* g_post, const float* mod_y, int i_gate,
                                              float* xout_p, bf16* xout_pb, float* xout_s, const float* g_pre, const float* mod_h, int i_shift, int i_scale, bf16* H) {
    for (int row = c.gw; row < MT; row += c.NGW) {
        int lane_ = c.lane; asm volatile("" : "+v"(lane_));
        const int cr = row < MP ? row / SEQ : BATCH + (row - MP);
        f32x4 x[8];
        if (row < MP && xin_pb) {
            const v2u* xb = (const v2u*)(xin_pb + (size_t)row * D_MODEL) + lane_;
#pragma unroll
            for (int j = 0; j < 8; ++j) { const v2u w = xb[64 * j]; x[j] = (f32x4){blo(w.x), bhi(w.x), blo(w.y), bhi(w.y)}; }
        } else {
            const f32x4* xr = (const f32x4*)(row < MP ? xin_p + (size_t)row * D_MODEL : xin_s + (size_t)(row - MP) * D_MODEL) + lane_;
#pragma unroll
            for (int j = 0; j < 8; ++j) x[j] = xr[64 * j];
        }
        if (y) {
            const v2u* yr = (const v2u*)(y + (size_t)row * D_MODEL) + lane_;
            const f32x4* gp = (const f32x4*)g_post + lane_;
            const f32x4* gt = (const f32x4*)(mod_y + (size_t)cr * (N_MOD * D_MODEL) + (size_t)i_gate * D_MODEL) + lane_;
            f32x4 v[8], gpv[8], gtv[8]; float ss = 0.f;
#pragma unroll
            for (int j = 0; j < 8; ++j) { const v2u yw = yr[64 * j]; v[j] = (f32x4){blo(yw.x), bhi(yw.x), blo(yw.y), bhi(yw.y)}; gpv[j] = gp[64 * j]; gtv[j] = gt[64 * j]; }
#pragma unroll
            for (int j = 0; j < 8; ++j) ss += (v[j].x * v[j].x + v[j].y * v[j].y) + (v[j].z * v[j].z + v[j].w * v[j].w);
            const float rstd = 1.0f / sqrtf(wave_sum(ss) * (1.0f / D_MODEL) + EPS);
#pragma unroll
            for (int j = 0; j < 8; ++j) x[j] = x[j] + gtv[j] * (v[j] * rstd * gpv[j]);
        }
        asm volatile("" ::: "memory");
        f32x4 g2[8], shv[8], slv[8];
        if (g_pre) {
            const f32x4* gp = (const f32x4*)g_pre + lane_;
            const f32x4* sh = (const f32x4*)(mod_h + (size_t)cr * (N_MOD * D_MODEL) + (size_t)i_shift * D_MODEL) + lane_;
            const f32x4* sl = (const f32x4*)(mod_h + (size_t)cr * (N_MOD * D_MODEL) + (size_t)i_scale * D_MODEL) + lane_;
#pragma unroll
            for (int j = 0; j < 8; ++j) { g2[j] = gp[64 * j]; shv[j] = sh[64 * j]; slv[j] = sl[64 * j]; }
        }
        if (y) {
            if (row < MP && xout_pb) { v2u* xo = (v2u*)(xout_pb + (size_t)row * D_MODEL) + lane_;
#pragma unroll
                for (int j = 0; j < 8; ++j) { v2u w; w.x = pk2(x[j].x, x[j].y); w.y = pk2(x[j].z, x[j].w); xo[64 * j] = w;
                    x[j] = (f32x4){blo(w.x), bhi(w.x), blo(w.y), bhi(w.y)}; }
            } else { f32x4* xo = (f32x4*)(row < MP ? xout_p + (size_t)row * D_MODEL : xout_s + (size_t)(row - MP) * D_MODEL) + lane_;
#pragma unroll
                for (int j = 0; j < 8; ++j) xo[64 * j] = x[j]; } }
        if (g_pre) {
            float ss = 0.f;
#pragma unroll
            for (int j = 0; j < 8; ++j) ss += (x[j].x * x[j].x + x[j].y * x[j].y) + (x[j].z * x[j].z + x[j].w * x[j].w);
            const float rstd = 1.0f / sqrtf(wave_sum(ss) * (1.0f / D_MODEL) + EPS);
            v2u* ho = (v2u*)(H + (size_t)row * D_MODEL) + lane_;
#pragma unroll
            for (int j = 0; j < 8; ++j) { const f32x4 hv = x[j] * rstd * g2[j] * (slv[j] + 1.0f) + shv[j]; v2u w; w.x = pk2(hv.x, hv.y); w.y = pk2(hv.z, hv.w); ho[64 * j] = w; }
        }
    }
}

template <class F>
__device__ __forceinline__ void gemv8(const Ctx& c, int fw, int nfw, const bf16* A8, int lda, int K, const bf16* Bt, int ldb, int N, const F f) {
    const int kc = K / 8;
    for (int n = fw; n < N; n += nfw) {
        float acc[8];
#pragma unroll
        for (int r = 0; r < 8; ++r) acc[r] = 0.f;
        const bf16* br = Bt + (size_t)n * ldb;
        for (int ch = c.lane; ch < kc; ch += 64) { const v4u b = *(const v4u*)(br + ch * 8);
            v4u a[8];
#pragma unroll
            for (int r = 0; r < 8; ++r) a[r] = *(const v4u*)(A8 + (size_t)r * lda + ch * 8);
#pragma unroll
            for (int r = 0; r < 8; ++r) acc[r] = dot8(a[r], b, acc[r]); }
        const float v = reduce8(acc, c.lane);
        if ((c.lane & 7) == 0) f(n, ((c.lane >> 5) & 1) * 4 + ((c.lane >> 4) & 1) * 2 + ((c.lane >> 3) & 1), v);
    }
}
__device__ __forceinline__ void gemv8_branch(const Ctx& c, const bf16* A8  , const bf16* Bt  , const bf16* Y1s  , bf16* MGs) {
    constexpr int kc = K_BR / 8;
    for (int n = c.gw; n < D_MODEL; n += c.NGW) {
        float acc[3][8];
#pragma unroll
        for (int s = 0; s < 3; ++s)
#pragma unroll
            for (int r = 0; r < 8; ++r) acc[s][r] = 0.f;
        const bf16* br = Bt + (size_t)n * K_BR;
#pragma unroll
        for (int s = 0; s < 3; ++s) { const int ch = c.lane + 64 * s;
            if (ch < kc) { const v4u b = *(const v4u*)(br + ch * 8);
                v4u a[8];
#pragma unroll
                for (int r = 0; r < 8; ++r) a[r] = *(const v4u*)(A8 + (size_t)r * K_BR + ch * 8);
#pragma unroll
                for (int r = 0; r < 8; ++r) acc[s][r] = dot8(a[r], b, acc[s][r]); } }
        const float v0 = reduce8(acc[0], c.lane), v1 = reduce8(acc[1], c.lane), v2 = reduce8(acc[2], c.lane);
        const int rr = ((c.lane >> 5) & 1) * 4 + ((c.lane >> 4) & 1) * 2 + ((c.lane >> 3) & 1);
        if ((c.lane & 7) == 0) { const bf16* gl = Y1s + (size_t)rr * N_IN + OFF_GL + n;
            const float m = sigmoidf_(bf2f(gl[0])) * v0 + sigmoidf_(bf2f(gl[D_MODEL])) * v1 + sigmoidf_(bf2f(gl[2 * D_MODEL])) * v2;
            MGs[(size_t)rr * D_MODEL + n] = (bf16)f2bf(m); }
    }
}

typedef short bf16x8_t __attribute__((ext_vector_type(8)));
typedef short s16x4_t __attribute__((ext_vector_type(4)));
typedef float f32x4_t __attribute__((ext_vector_type(4)));
constexpr int AT_RS = 160;
constexpr int AT_K = 0, AT_V = 256 * AT_RS, AT_BIAS = 2 * 256 * AT_RS;
__device__ __forceinline__ s16x4_t vtr(const LAS unsigned char* p) { return __builtin_bit_cast(s16x4_t, __builtin_amdgcn_ds_read_tr16_b64_v4i16((LAS s16x4_t*)p)); }
struct AttnPre { v4u kv[4], vv[4]; float bias; bf16x8_t q0, q1; };
__device__ __forceinline__ void attn_prefetch(const bf16* Y, const float* biasT, int item, int tid, AttnPre& P) {
    const int lane = tid & 63, w = __builtin_amdgcn_readfirstlane(tid >> 6);
    const int b = item / 384, g = (item / 128) % 3, h = (item / 32) % 4, idx = item % 32;
    const int dil = (g == 0) ? 1 : (g == 1 ? 4 : 16), nbc = 32 / dil, r = idx / nbc, i0 = (idx % nbc) * 128;
    const int co = g * 256 + h * 64;
    const bf16* Yb = Y + (size_t)b * SEQ * N_IN;
#pragma unroll
    for (int ps = 0; ps < 4; ++ps) { const int rowl = ps * 64 + (tid >> 3), ch = tid & 7, ik = i0 - 128 + rowl;
        P.kv[ps] = (v4u){0u, 0u, 0u, 0u}; P.vv[ps] = (v4u){0u, 0u, 0u, 0u};
        if (ik >= 0) { const bf16* src = Yb + (size_t)(ik * dil + r) * N_IN + co + ch * 8; P.kv[ps] = *(const v4u*)(src + OFF_K); P.vv[ps] = *(const v4u*)(src + OFF_V); } }
    P.bias = (tid < 129) ? biasT[(g * 4 + h) * 129 + tid] : 0.f;
    const int a = lane & 15, quad = lane >> 4, tq = (i0 + 16 * w + a) * dil + r;
    const bf16* qp = Yb + (size_t)tq * N_IN + OFF_Q + co + 8 * quad; P.q0 = *(const bf16x8_t*)qp; P.q1 = *(const bf16x8_t*)(qp + 32);
}
__device__ __forceinline__ void attn_block_items(const bf16* Y, const float* biasT, bf16* OG, float* LSE, int first, int step, int nitems, LAS unsigned char* lds, int tid) {
  if (first >= nitems) return;
  AttnPre P;
  attn_prefetch(Y, biasT, first, tid, P);
  for (int item = first;;) {
    const int lane = tid & 63, w = __builtin_amdgcn_readfirstlane(tid >> 6);
    const int b = item / 384, g = (item / 128) % 3, h = (item / 32) % 4, idx = item % 32;
    const int dil = (g == 0) ? 1 : (g == 1 ? 4 : 16), nbc = 32 / dil, r = idx / nbc, i0 = (idx % nbc) * 128;
#pragma unroll
    for (int ps = 0; ps < 4; ++ps) { const int rowl = ps * 64 + (tid >> 3), ch = tid & 7;
        *(LAS v4u*)(lds + AT_K + rowl * AT_RS + ch * 16) = P.kv[ps]; *(LAS v4u*)(lds + AT_V + rowl * AT_RS + ch * 16) = P.vv[ps]; }
    if (tid < 129) ((LAS float*)(lds + AT_BIAS))[tid] = P.bias;
    bf16x8_t qf[2]; qf[0] = P.q0; qf[1] = P.q1;
    __syncthreads();
    const int nxt = item + step;
    if (nxt < nitems) attn_prefetch(Y, biasT, nxt, tid, P);
    const int a = lane & 15, quad = lane >> 4;
    const int tq = (i0 + 16 * w + a) * dil + r;
    f32x4_t sc[9];
#pragma unroll
    for (int j = 0; j < 9; ++j) { const LAS unsigned char* kp = lds + AT_K + (16 * w + 16 * j + a) * AT_RS + 16 * quad;
        const bf16x8_t k0 = *(const LAS bf16x8_t*)kp, k1 = *(const LAS bf16x8_t*)(kp + 64);
        f32x4_t acc = (f32x4_t){0.f, 0.f, 0.f, 0.f};
        acc = __builtin_amdgcn_mfma_f32_16x16x32_bf16(k0, qf[0], acc, 0, 0, 0);
        acc = __builtin_amdgcn_mfma_f32_16x16x32_bf16(k1, qf[1], acc, 0, 0, 0);
        sc[j] = acc; }
    const LAS float* sb = (const LAS float*)(lds + AT_BIAS);
    float m = -1e30f;
#pragma unroll
    for (int j = 0; j < 9; ++j)
#pragma unroll
        for (int e = 0; e < 4; ++e) { const int kk = 16 * j + 4 * quad + e, dist = a + 128 - kk, ik = i0 + 16 * w - 128 + kk;
            const bool valid = (dist >= 0) && (dist <= 128) && (ik >= 0);
            const int dc = dist < 0 ? 0 : (dist > 128 ? 128 : dist);
            const float s = valid ? sc[j][e] * 0.125f + sb[dc] : -1e30f;
            sc[j][e] = s; m = fmaxf(m, s); }
    m = fmaxf(m, __shfl_xor(m, 16)); m = fmaxf(m, __shfl_xor(m, 32));
    float l = 0.f;
#pragma unroll
    for (int j = 0; j < 9; ++j)
#pragma unroll
        for (int e = 0; e < 4; ++e) { const float pv = (sc[j][e] > -1e29f) ? __expf(sc[j][e] - m) : 0.f; sc[j][e] = pv; l += pv; }
    l += __shfl_xor(l, 16); l += __shfl_xor(l, 32);
    f32x4_t oacc[4];
#pragma unroll
    for (int dt = 0; dt < 4; ++dt) oacc[dt] = (f32x4_t){0.f, 0.f, 0.f, 0.f};
    const LAS unsigned char* vbase = lds + AT_V + (16 * w + 4 * quad + ((lane & 15) >> 2)) * AT_RS + 8 * (lane & 3);
#pragma unroll
    for (int ss = 0; ss < 5; ++ss) {
        v4u pw; pw.x = pk2(sc[2 * ss][0], sc[2 * ss][1]); pw.y = pk2(sc[2 * ss][2], sc[2 * ss][3]);
        if (ss < 4) { pw.z = pk2(sc[2 * ss + 1][0], sc[2 * ss + 1][1]); pw.w = pk2(sc[2 * ss + 1][2], sc[2 * ss + 1][3]); } else { pw.z = 0u; pw.w = 0u; }
        const bf16x8_t pb = __builtin_bit_cast(bf16x8_t, pw);
#pragma unroll
        for (int dt = 0; dt < 4; ++dt) {
            const s16x4_t lo = vtr(vbase + (32 * ss) * AT_RS + 32 * dt);
            s16x4_t hi = (s16x4_t){0, 0, 0, 0};
            if (ss < 4) hi = vtr(vbase + (32 * ss + 16) * AT_RS + 32 * dt);
            bf16x8_t va; va[0] = lo[0]; va[1] = lo[1]; va[2] = lo[2]; va[3] = lo[3]; va[4] = hi[0]; va[5] = hi[1]; va[6] = hi[2]; va[7] = hi[3];
            oacc[dt] = __builtin_amdgcn_mfma_f32_16x16x32_bf16(va, pb, oacc[dt], 0, 0, 0);
        }
    }
    const float il = 1.0f / l;
    bf16* op = OG + ((size_t)(b * SEQ + tq) * 3 + g) * 256 + h * 64 + 4 * quad;
#pragma unroll
    for (int dt = 0; dt < 4; ++dt) { v2u o; o.x = pk2(oacc[dt][0] * il, oacc[dt][1] * il); o.y = pk2(oacc[dt][2] * il, oacc[dt][3] * il); *(v2u*)(op + 16 * dt) = o; }
    if (quad == 0) LSE[((size_t)(b * SEQ + tq) * 3 + g) * 4 + h] = m + __logf(l);
    __syncthreads();
    if (nxt >= nitems) break;
    item = nxt;
  }
}
__device__ __forceinline__ void attn_combine_phase(const Ctx& c, const bf16* OG, const float* LSE, bf16* A2) {
    const int h = c.lane >> 4, d4 = (c.lane & 15) * 4;
    for (int tok = c.gw; tok < MT; tok += c.NGW) {
        const float l0 = LSE[(size_t)tok * 12 + h], l1 = LSE[(size_t)tok * 12 + 4 + h], l2 = LSE[(size_t)tok * 12 + 8 + h];
        const float mm = fmaxf(l0, fmaxf(l1, l2));
        const float w0 = __expf(l0 - mm), w1 = __expf(l1 - mm), w2 = __expf(l2 - mm), iw = 1.0f / (w0 + w1 + w2);
        const bf16* op = OG + (size_t)tok * 768 + h * 64 + d4;
        const v2u a0 = *(const v2u*)op, a1 = *(const v2u*)(op + 256), a2 = *(const v2u*)(op + 512);
        v2u o;
        o.x = pk2((w0 * blo(a0.x) + w1 * blo(a1.x) + w2 * blo(a2.x)) * iw, (w0 * bhi(a0.x) + w1 * bhi(a1.x) + w2 * bhi(a2.x)) * iw);
        o.y = pk2((w0 * blo(a0.y) + w1 * blo(a1.y) + w2 * blo(a2.y)) * iw, (w0 * bhi(a0.y) + w1 * bhi(a1.y) + w2 * bhi(a2.y)) * iw);
        *(v2u*)(A2 + (size_t)tok * K_BR + 1024 + h * 64 + d4) = o;
    }
}
__device__ __forceinline__ void attn_sample_item(const PL p, const bf16* Y, const float* biasT, bf16* OG, float* LSE, int layer, int bs, int h, int g, LAS float* ps, int lane) {
    const int row = MP + bs;
    const int dil = (g == 0) ? 1 : (g == 1 ? 4 : 16), Lc = 128 * dil;
    const float* cache = (g == 0 ? p.c128() : (g == 1 ? p.c512() : p.c2048())) + (size_t)(layer * DEC_BATCH + bs) * Lc * 512;
    const int co = g * 256 + h * 64;
    float q[64];
    { const v4u* qp = (const v4u*)(Y + (size_t)row * N_IN + OFF_Q + co);
#pragma unroll
      for (int i = 0; i < 8; ++i) { float f[8]; unpack8(qp[i], f);
#pragma unroll
          for (int e = 0; e < 8; ++e) q[8 * i + e] = f[e]; } }
    float s[3];
#pragma unroll
    for (int j = 0; j < 3; ++j) { const int n = lane + 64 * j; s[j] = -1e30f;
        if (n <= 128) { float d = 0.f;
            if (n == 0) { const v4u* kp = (const v4u*)(Y + (size_t)row * N_IN + OFF_K + co);
#pragma unroll
                for (int i = 0; i < 8; ++i) { float f[8]; unpack8(kp[i], f);
#pragma unroll
                    for (int e = 0; e < 8; ++e) d = fmaf(q[8 * i + e], f[e], d); } }
            else { const f32x4* kp = (const f32x4*)(cache + (size_t)(Lc - n * dil) * 512 + h * 64);
#pragma unroll
                for (int i = 0; i < 16; ++i) { const f32x4 kv = kp[i]; d = fmaf(q[4 * i], kv.x, d); d = fmaf(q[4 * i + 1], kv.y, d); d = fmaf(q[4 * i + 2], kv.z, d); d = fmaf(q[4 * i + 3], kv.w, d); } }
            s[j] = d * 0.125f + biasT[(g * 4 + h) * 129 + n]; } }
    const float m = wave_max(fmaxf(s[0], fmaxf(s[1], s[2])));
    float pj[3], l = 0.f;
#pragma unroll
    for (int j = 0; j < 3; ++j) { pj[j] = (s[j] > -1e29f) ? __expf(s[j] - m) : 0.f; l += pj[j]; }
    l = wave_sum(l);
    LDS_FENCE();
#pragma unroll
    for (int j = 0; j < 3; ++j) ps[lane + 64 * j] = pj[j];
    LDS_FENCE();
    const int d4 = 4 * (lane & 15), kq = lane >> 4;
    f32x4 o = (f32x4){0.f, 0.f, 0.f, 0.f};
    const float* vb = cache + (size_t)Lc * 512 + 256 + h * 64 + d4;
#pragma unroll 8
    for (int i = 0; i < 32; ++i) { const int n = 4 * i + kq + 1; const f32x4 vv = *(const f32x4*)(vb - (long)n * dil * 512); o = o + vv * ps[n]; }
    if (kq == 0) { const v2u w = *(const v2u*)(Y + (size_t)row * N_IN + OFF_V + co + d4); const float p0 = ps[0];
        o.x = fmaf(p0, blo(w.x), o.x); o.y = fmaf(p0, bhi(w.x), o.y); o.z = fmaf(p0, blo(w.y), o.z); o.w = fmaf(p0, bhi(w.y), o.w); }
#pragma unroll
    for (int e = 0; e < 4; ++e) { float t = o[e]; t += __shfl_xor(t, 16); t += __shfl_xor(t, 32); o[e] = t; }
    const float il = 1.0f / l;
    if (kq == 0) { v2u w; w.x = pk2(o.x * il, o.y * il); w.y = pk2(o.z * il, o.w * il); *(v2u*)(OG + ((size_t)row * 3 + g) * 256 + h * 64 + d4) = w; }
    if (lane == 0) LSE[((size_t)row * 3 + g) * 4 + h] = m + __logf(l);
    LDS_FENCE();
}
__device__ __forceinline__ void poolconv_row(const PL p, const bf16* Y, bf16* A2, int layer, int row, int lane) {
    const bf16* yr = Y + (size_t)row * N_IN;
    const int c0 = lane * 8, w = 2 << (lane >> 4);
    float cur[8], s[8];
    unpack8(*(const v4u*)(yr + OFF_P + c0), cur);
#pragma unroll
    for (int j = 0; j < 8; ++j) s[j] = cur[j];
    float inv;
    if (row < MP) { const int t = row % SEQ, cnt = (t + 1 < w) ? (t + 1) : w;
        for (int i = 1; i < cnt; ++i) { float f[8]; unpack8(*(const v4u*)(yr - (size_t)i * N_IN + OFF_P + c0), f);
#pragma unroll
            for (int j = 0; j < 8; ++j) s[j] += f[j]; }
        inv = 1.0f / (float)cnt;
    } else { const float* st = p.state_pool() + (size_t)(layer * DEC_BATCH + (row - MP)) * 15 * 512 + c0;
        for (int i = 1; i < w; ++i) { const f32x4 a = *(const f32x4*)(st + (size_t)(15 - i) * 512), b = *(const f32x4*)(st + (size_t)(15 - i) * 512 + 4);
            s[0] += a.x; s[1] += a.y; s[2] += a.z; s[3] += a.w; s[4] += b.x; s[5] += b.y; s[6] += b.z; s[7] += b.w; }
        inv = 1.0f / (float)w; }
    float pm[8];
#pragma unroll
    for (int j = 0; j < 8; ++j) pm[j] = s[j] * inv - cur[j];
    float gb[8], gc[8], hc[8], u0[8], u1[8], u2[8];
    unpack8(*(const v4u*)(yr + OFF_GB + c0), gb); unpack8(*(const v4u*)(yr + OFF_GC + c0), gc); unpack8(*(const v4u*)(yr + OFF_HC + c0), hc);
#pragma unroll
    for (int j = 0; j < 8; ++j) { u0[j] = gc[j] * hc[j]; u1[j] = 0.f; u2[j] = 0.f; }
    if (row < MP) { const int t = row % SEQ;
        if (t >= 1) { unpack8(*(const v4u*)(yr - N_IN + OFF_GC + c0), gc); unpack8(*(const v4u*)(yr - N_IN + OFF_HC + c0), hc);
#pragma unroll
            for (int j = 0; j < 8; ++j) u1[j] = gc[j] * hc[j]; }
        if (t >= 2) { unpack8(*(const v4u*)(yr - 2 * N_IN + OFF_GC + c0), gc); unpack8(*(const v4u*)(yr - 2 * N_IN + OFF_HC + c0), hc);
#pragma unroll
            for (int j = 0; j < 8; ++j) u2[j] = gc[j] * hc[j]; }
    } else { const float* st = p.state_conv() + (size_t)(layer * DEC_BATCH + (row - MP)) * 2 * 512 + c0;
#pragma unroll
        for (int j = 0; j < 8; ++j) { u2[j] = st[j]; u1[j] = st[512 + j]; } }
    const float* cw = p.conv_w() + (size_t)layer * 3 * 512 + c0;
    float cb[8];
#pragma unroll
    for (int j = 0; j < 8; ++j) cb[j] = gb[j] * (u2[j] * cw[j] + u1[j] * cw[512 + j] + u0[j] * cw[1024 + j]);
    *(v4u*)(A2 + (size_t)row * K_BR + c0) = pack8(pm);
    *(v4u*)(A2 + (size_t)row * K_BR + 512 + c0) = pack8(cb);
}
__device__ __forceinline__ void mixer_phase(const PL p, const Ctx& c, int layer, unsigned char* ws, float* outp) {
    const bf16* Y = (const bf16*)(ws + WS_Y); bf16* A2 = (bf16*)(ws + WS_A2); const float* biasT = (const float*)(ws + WS_BIAS);
    LAS float* ps = (LAS float*)(c.lds + c.wave * 1024);
    float* out = outp;
    const int gtid = c.gw * 64 + c.lane, gsz = c.NGW * 64;
    { constexpr int NQ = BATCH * (128 + 512 + 2048) * 64;
      for (int q0 = gtid; q0 < NQ; q0 += 4 * gsz) {
          v4u v[4]; float* dst[4];
#pragma unroll
          for (int u = 0; u < 4; ++u) { const int q = q0 + u * gsz; dst[u] = nullptr;
              if (q < NQ) { const int pidx = q >> 6, ch = q & 63, b = pidx / 2688, pp = pidx % 2688, g = pp < 128 ? 0 : (pp < 640 ? 1 : 2), j = pp - (g == 0 ? 0 : (g == 1 ? 128 : 640)), w = 128 << (2 * g);
                  v[u] = *(const v4u*)(Y + (size_t)(b * SEQ + SEQ - w + j) * N_IN + ((ch >> 5) ? OFF_V : OFF_K) + g * 256 + (ch & 31) * 8);
                  dst[u] = out + (g == 0 ? O_KVP0 : (g == 1 ? O_KVP1 : O_KVP2)) + (size_t)layer * (BATCH * w * 512) + ((size_t)(b * w + j) * 512 + ch * 8); } }
#pragma unroll
          for (int u = 0; u < 4; ++u) if (dst[u]) { float f[8]; unpack8(v[u], f); *(f32x4*)dst[u] = (f32x4){f[0], f[1], f[2], f[3]}; *(f32x4*)(dst[u] + 4) = (f32x4){f[4], f[5], f[6], f[7]}; } } }
    { constexpr int N0 = 3 * DEC_BATCH * 512, N1 = N0 + BATCH * 15 * 512, N2 = N1 + DEC_BATCH * 15 * 512, N3 = N2 + BATCH * 2 * 512, N4 = N3 + DEC_BATCH * 2 * 512;
      static_assert(N4 <= 256 * NTHREADS, "one element per thread");
      int i = gtid; float val = 0.f; float* dst = nullptr;
      if (i < N0) { const int g = i / (DEC_BATCH * 512), ii = i % (DEC_BATCH * 512), hd = ii & 255, kv = (ii >> 8) & 1, b = ii >> 9;
          val = bf2f(Y[(size_t)(MP + b) * N_IN + (kv ? OFF_V : OFF_K) + g * 256 + hd]); dst = out + (g == 0 ? O_KVS0 : (g == 1 ? O_KVS1 : O_KVS2)) + (size_t)layer * DEC_BATCH * 512 + ii; }
      else if (i < N1) { i -= N0; const int cc = i & 511, j = (i >> 9) % 15, b = (i >> 9) / 15;
          val = bf2f(Y[(size_t)(b * SEQ + SEQ - 15 + j) * N_IN + OFF_P + cc]); dst = out + O_POOLP + (size_t)layer * BATCH * 15 * 512 + i; }
      else if (i < N2) { i -= N1; const int cc = i & 511, j = (i >> 9) % 15, b = (i >> 9) / 15;
          val = (j < 14) ? p.state_pool()[((size_t)(layer * DEC_BATCH + b) * 15 + j + 1) * 512 + cc] : bf2f(Y[(size_t)(MP + b) * N_IN + OFF_P + cc]); dst = out + O_POOLS + (size_t)layer * DEC_BATCH * 15 * 512 + i; }
      else if (i < N3) { i -= N2; const int cc = i & 511, j = (i >> 9) & 1, b = i >> 10; const bf16* yr = Y + (size_t)(b * SEQ + SEQ - 2 + j) * N_IN;
          val = bf2f(yr[OFF_GC + cc]) * bf2f(yr[OFF_HC + cc]); dst = out + O_CONVP + (size_t)layer * BATCH * 2 * 512 + i; }
      else if (i < N4) { i -= N3; const int cc = i & 511, j = (i >> 9) & 1, b = i >> 10; const bf16* yr = Y + (size_t)(MP + b) * N_IN;
          val = (j == 0) ? p.state_conv()[((size_t)(layer * DEC_BATCH + b) * 2 + 1) * 512 + cc] : bf2f(yr[OFF_GC + cc]) * bf2f(yr[OFF_HC + cc]); dst = out + O_CONVS + (size_t)layer * DEC_BATCH * 2 * 512 + i; }
      if (dst) *dst = val; }
    constexpr int NB0 = 32;
    if (c.bid < NB0) return;
    const int mb = c.bid - NB0, mG = c.G - NB0, mgw = mb * NWAVES + c.wave, mNGW = mG * NWAVES;
    for (int row = mgw; row < MT; row += mNGW) poolconv_row(p, Y, A2, layer, row, c.lane);
    if (c.wave == 0 && mb < DEC_BATCH * 12) { const int it = mb; attn_sample_item(p, Y, biasT, (bf16*)(ws + WS_OG), (float*)(ws + WS_LSE), layer, it / 12, (it / 3) % 4, it % 3, ps, c.lane); }
    __syncthreads();
    attn_block_items(Y, biasT, (bf16*)(ws + WS_OG), (float*)(ws + WS_LSE), mb, mG, BATCH * 3 * 4 * 32, c.lds, c.tid);
}

__device__ __forceinline__ void ffnact_phase(const PL p, const Ctx& c, int layer, unsigned char* ws, float* outp) {
    const bf16* UP = (const bf16*)(ws + WS_Y); bf16* ACT = (bf16*)(ws + WS_ACT);
    const float* fw = p.ffn_conv_w() + (size_t)layer * 3 * N_UP;
    const int gtid = c.gw * 64 + c.lane, gsz = c.NGW * 64;
    constexpr int CH = D_FF / 8;
    for (int idx = gtid; idx < (MP / 32 + DEC_BATCH) * CH; idx += gsz) {
        const int ri = idx / CH, j0 = (idx % CH) * 8, row = ri < MP / 32 ? (ri >> 1) * 64 + (ri & 1) : MP + (ri - MP / 32);
        const bf16* r0 = UP + (size_t)row * N_UP;
        float a[8], b[8], ga[8], va[8];
        unpack8(*(const v4u*)(r0 + j0), ga); unpack8(*(const v4u*)(r0 + D_FF + j0), va);
#pragma unroll
        for (int j = 0; j < 8; ++j) { a[j] = ga[j] * fw[2 * N_UP + j0 + j]; b[j] = va[j] * fw[2 * N_UP + D_FF + j0 + j]; }
        if (row < MP) { const int t = row % SEQ;
            if (t >= 1) { unpack8(*(const v4u*)(r0 - N_UP + j0), ga); unpack8(*(const v4u*)(r0 - N_UP + D_FF + j0), va);
#pragma unroll
                for (int j = 0; j < 8; ++j) { a[j] = fmaf(ga[j], fw[N_UP + j0 + j], a[j]); b[j] = fmaf(va[j], fw[N_UP + D_FF + j0 + j], b[j]); } }
            if (t >= 2) { unpack8(*(const v4u*)(r0 - 2 * N_UP + j0), ga); unpack8(*(const v4u*)(r0 - 2 * N_UP + D_FF + j0), va);
#pragma unroll
                for (int j = 0; j < 8; ++j) { a[j] = fmaf(ga[j], fw[j0 + j], a[j]); b[j] = fmaf(va[j], fw[D_FF + j0 + j], b[j]); } }
        } else { const float* st = p.state_ffn() + (size_t)(layer * DEC_BATCH + (row - MP)) * 2 * N_UP;
#pragma unroll
            for (int j = 0; j < 8; ++j) { a[j] = fmaf(st[N_UP + j0 + j], fw[N_UP + j0 + j], a[j]); b[j] = fmaf(st[N_UP + D_FF + j0 + j], fw[N_UP + D_FF + j0 + j], b[j]);
                                          a[j] = fmaf(st[j0 + j], fw[j0 + j], a[j]); b[j] = fmaf(st[D_FF + j0 + j], fw[D_FF + j0 + j], b[j]); } }
        float o[8];
#pragma unroll
        for (int j = 0; j < 8; ++j) o[j] = gelu_tanh(a[j]) * b[j];
        *(v4u*)(ACT + (size_t)row * D_FF + j0) = pack8(o);
    }
    float* out = outp;
    for (int i = gtid; i < BATCH * 2 * N_UP; i += gsz) { const int cc = i % N_UP, j = (i / N_UP) & 1, b = i / (2 * N_UP);
        out[O_FFNP + (size_t)layer * BATCH * 2 * N_UP + i] = bf2f(UP[(size_t)(b * SEQ + SEQ - 2 + j) * N_UP + cc]); }
    for (int i = gtid; i < DEC_BATCH * 2 * N_UP; i += gsz) { const int cc = i % N_UP, j = (i / N_UP) & 1, b = i / (2 * N_UP);
        out[O_FFNS + (size_t)layer * DEC_BATCH * 2 * N_UP + i] = (j == 0) ? p.state_ffn()[((size_t)(layer * DEC_BATCH + b) * 2 + 1) * N_UP + cc] : bf2f(UP[(size_t)(MP + b) * N_UP + cc]); }
}


#define XB_TMO      128
#define XB_XCNT(j)  (256  + 64 * (j))
#define XB_XSUB(j)  (1280 + 64 * (j))
#define XB_XGEN(j)  (2304 + 64 * (j))
#define XB_TOP      3328
#define XB_TOPGEN   3392
#define XCD_BAR_WORDS 3456
#define XB_SPIN_CAP (1u << 22)
__device__ __forceinline__ unsigned xb_ld(unsigned* p)              { return __hip_atomic_load(p, __ATOMIC_RELAXED, __HIP_MEMORY_SCOPE_AGENT); }
__device__ __forceinline__ unsigned xb_add(unsigned* p, unsigned v) { return __hip_atomic_fetch_add(p, v, __ATOMIC_RELAXED, __HIP_MEMORY_SCOPE_AGENT); }
__device__ __forceinline__ unsigned xb_xcc_id() { return (unsigned)__builtin_amdgcn_s_getreg((3 << 11) | 20) & 0xFu; }
#define XB_SPIN(cond, bar) do { unsigned _sp = 0; while (cond) { __builtin_amdgcn_s_sleep(1); \
    if ((++_sp & 255u) == 0u) { if (xb_ld(&(bar)[XB_TMO])) break; if (_sp > XB_SPIN_CAP) { atomicAdd(&(bar)[XB_TMO], 1u); break; } } } } while (0)
__device__ __forceinline__ void xcd_barrier_complete(unsigned* bar, unsigned x, unsigned G, unsigned& nloc, unsigned& nx) {
    unsigned sum, cnt, mine, sp = 0u;
    for (;;) {
        sum = 0u; cnt = 0u; mine = 0u;
#pragma unroll
        for (unsigned j = 0; j < 16; ++j) { const unsigned c = xb_ld(&bar[XB_XCNT(j)]); sum += c; cnt += (c > 0u) ? 1u : 0u; mine = (j == x) ? c : mine; }
        if (sum == G) break;
        __builtin_amdgcn_s_sleep(1);
        if ((++sp & 255u) == 0u) { if (xb_ld(&bar[XB_TMO])) break; if (sp > XB_SPIN_CAP) { atomicAdd(&bar[XB_TMO], 1u); break; } }
    }
    nloc = mine > 0u ? mine : 1u; nx = cnt > 0u ? cnt : 1u;
}
__device__ __forceinline__ void xcd_barrier(unsigned* bar, volatile LAS unsigned* st, unsigned G) {
    asm volatile("s_waitcnt vmcnt(0)" ::: "memory");
    __syncthreads();
    if (threadIdx.x == 0) {
        const unsigned x = xb_xcc_id();
        __builtin_amdgcn_s_waitcnt(0);
        unsigned nloc = st[0], nx = st[1];
        if (nloc == 0u) { xcd_barrier_complete(bar, x, G, nloc, nx); st[0] = nloc; st[1] = nx;
            bool even = (nx == 8u);
#pragma unroll
            for (unsigned j = 0; j < 8; ++j) even = even && (xb_ld(&bar[XB_XCNT(j)]) * 8u == G);
            st[4] = even ? 1u : 0u; }
        const unsigned old = xb_add(&bar[XB_XSUB(x)], 1u);
        const unsigned gen = old / nloc;
        if (old + 1u == (gen + 1u) * nloc) {
            __builtin_amdgcn_fence(__ATOMIC_RELEASE, "agent");
            asm volatile("s_waitcnt vmcnt(0)" ::: "memory");
            const unsigned og = xb_add(&bar[XB_TOP], 1u);
            const unsigned tg = og / nx;
            if (og + 1u == (tg + 1u) * nx) xb_add(&bar[XB_TOPGEN], 1u);
            else XB_SPIN(xb_ld(&bar[XB_TOPGEN]) == tg, bar);
            __builtin_amdgcn_fence(__ATOMIC_ACQUIRE, "agent");
            xb_add(&bar[XB_XGEN(x)], 1u);
            asm volatile("s_waitcnt vmcnt(0)" ::: "memory");
        } else {
            XB_SPIN(xb_ld(&bar[XB_XGEN(x)]) == gen, bar);
            __builtin_amdgcn_fence(__ATOMIC_ACQUIRE, "agent");
            asm volatile("s_waitcnt vmcnt(0)" ::: "memory");
        }
    }
    __syncthreads();
}

constexpr int PPL = 10;
constexpr int N_PHASES = 3 + DEPTH * PPL;
__global__ void __launch_bounds__(NTHREADS, 2) mk_fwd(Params prm) {
    extern __shared__ __attribute__((aligned(16))) unsigned char lds_raw[];
    { const unsigned* src = (const unsigned*)&prm; LAS unsigned* dst = (LAS unsigned*)((LAS unsigned char*)lds_raw + PARAM_LDS_OFF);
      for (int i = threadIdx.x; i < (int)(sizeof(Params) / 4); i += NTHREADS) dst[i] = src[i]; }
    volatile LAS unsigned* bar_st = (volatile LAS unsigned*)((LAS unsigned char*)lds_raw + 131072 + 512);
    if (threadIdx.x == 0) { bar_st[0] = 0u; bar_st[1] = 0u; bar_st[2] = 0u; bar_st[3] = 0u; bar_st[4] = 0u; }
    __syncthreads();
    const int ph_lo = prm.ph_lo, ph_hi = prm.ph_hi + prm.rc, rp = prm.rp, rc = prm.rc;
    if (ph_hi - ph_lo > 1 && threadIdx.x == 0) { const unsigned x = xb_xcc_id(); bar_st[2] = xb_add((unsigned*)(prm.ws + WS_CTL) + XB_XCNT(x), 1u); bar_st[3] = x; }
    for (int it = ph_lo; it < ph_hi; ++it) {
        const int ph = (it <= rp) ? it : (it <= rp + rc ? rp : it - rc);
        int tid_ = threadIdx.x, bid_ = blockIdx.x, G_ = gridDim.x;
        int lz_ = 0; asm volatile("" : "+s"(lz_));
        volatile LAS unsigned* bst = bar_st + lz_;
        if (bst[4] != 0u) bid_ = (int)(bst[2] * 8u + bst[3]);
        bid_ = __builtin_amdgcn_readfirstlane(bid_);
        PL p; p.b = (LAS const unsigned char*)lds_raw + PARAM_LDS_OFF + lz_; asm volatile("" ::: "memory");

        unsigned char* ws = (unsigned char*)p.ldp((int)offsetof(Params, ws)); float* outp = (float*)p.ldp((int)offsetof(Params, out));
        asm volatile("" : "+v"(tid_)); asm volatile("" : "+s"(bid_)); asm volatile("" : "+s"(G_));
        Ctx c;
        c.lds = (LAS unsigned char*)lds_raw; c.tid = tid_; c.lane = tid_ & 63; c.wave = __builtin_amdgcn_readfirstlane(tid_ >> 6);
        c.bid = bid_; c.G = G_; c.gw = bid_ * NWAVES + c.wave; c.NGW = G_ * NWAVES;
        const int G = G_;
        bf16* H = (bf16*)(ws + WS_H); bf16* Y = (bf16*)(ws + WS_Y); bf16* A2 = (bf16*)(ws + WS_A2); bf16* T = (bf16*)(ws + WS_T);
        bf16* MG = (bf16*)(ws + WS_MG); bf16* ACT = (bf16*)(ws + WS_ACT); float* XS = (float*)(ws + WS_XS); bf16* XB = (bf16*)(ws + WS_XB);
        const float* modb = (const float*)(ws + WS_MOD);
        float* yp = outp + O_YP; float* ys = outp + O_YS;
        if (ph == 0) phase_A(p, c, ws);
        else if (ph == 1) modsum_phase(p, c, ws);
        else if (ph == 2) rownorm_phase(c, p.x_prompt(), nullptr, p.x_sample(), nullptr, nullptr, nullptr, 0, nullptr, nullptr, nullptr, p.norm_g(), modb, 0, 1, H);
        else {
            const int l = (ph - 3) / PPL, spx = (ph - 3) % PPL, sp = spx <= 1 ? spx : spx - 1;
            const float* mod = modb + (size_t)l * NB * N_MOD * D_MODEL;
            const float* ng = p.norm_g() + (size_t)l * 4 * D_MODEL;
            const bf16* WTin = (const bf16*)(ws + WS_WTIN + l * SZ_WTIN); const bf16* WTbr = (const bf16*)(ws + WS_WTBR + l * SZ_WTBR);
            const bf16* WTo = (const bf16*)(ws + WS_WTO + l * SZ_WTO); const bf16* WTup = (const bf16*)(ws + WS_WTUP + l * SZ_WTUP); const bf16* WTdn = (const bf16*)(ws + WS_WTDN + l * SZ_WTDN);
            pg8::StaticOrder S;
            if (spx == 2) {
                attn_combine_phase(c, (const bf16*)(ws + WS_OG), (const float*)(ws + WS_LSE), A2);
            } else if (sp == 0) {
                pg8::Gemm g{H, WTin, MP, N_IN - 256, D_MODEL, D_MODEL, D_MODEL}; S.init(g, G, c.bid);
                pg8::EpiBf16 E{Y, N_IN, c.lds};
                pg8::gemm_phase<pg8::EpiBf16, true>(c.lds, c.tid, g, S, E);
                gemv8(c, c.gw, c.NGW, H + (size_t)MP * D_MODEL, D_MODEL, D_MODEL, WTin, D_MODEL, N_IN, StBf16{Y + (size_t)MP * N_IN, N_IN});
            } else if (sp == 1) {
                { pg8::Gemm g{H, WTin + (size_t)(N_IN - 256) * D_MODEL, MP, 256, D_MODEL, D_MODEL, D_MODEL}; S.init(g, G, c.bid);
                  pg8::EpiBf16 E{Y + (N_IN - 256), N_IN, c.lds};
                  pg8::gemm_phase<pg8::EpiBf16, true>(c.lds, c.tid, g, S, E); }
                mixer_phase(p, c, l, ws, outp);
            } else if (sp == 2) {
                { pg8::Gemm g{A2, WTbr, MP, D_MODEL, K_BR, K_BR, K_BR}; pg8::SegOrder S3; S3.init(g, c.bid);
                  pg8::EpiGate E{Y + OFF_GL, N_IN, MG};
                  pg8::gemm_phase<pg8::EpiGate, true>(c.lds, c.tid, g, S3, E); }
                gemv8_branch(c, A2 + (size_t)MP * K_BR, WTbr, Y + (size_t)MP * N_IN, MG + (size_t)MP * D_MODEL);
            } else if (sp == 3) {
                pg8::Gemm g{MG, WTo, MP, D_MODEL, D_MODEL, D_MODEL, D_MODEL}; S.init(g, G, c.bid);
                pg8::EpiBf16 E{T, D_MODEL, c.lds};
                pg8::gemm_phase<pg8::EpiBf16, false>(c.lds, c.tid, g, S, E);
                gemv8(c, c.gw, c.NGW, MG + (size_t)MP * D_MODEL, D_MODEL, D_MODEL, WTo, D_MODEL, D_MODEL, StBf16{T + (size_t)MP * D_MODEL, D_MODEL});
            } else if (sp == 4) {
                rownorm_phase(c, p.x_prompt(), l == 0 ? (const bf16*)nullptr : XB, l == 0 ? p.x_sample() : ys, T, ng + D_MODEL, mod, 2, nullptr, XB, XS, ng + 2 * D_MODEL, mod, 3, 4, H);
            } else if (sp == 5) {
                pg8::Gemm g{H, WTup, MP, N_UP, D_MODEL, D_MODEL, D_MODEL}; S.init(g, G, c.bid);
                EpiFfn E{ACT, Y, p.ffn_conv_w() + (size_t)l * 3 * N_UP};
                pg8::gemm_phase<EpiFfn, true>(c.lds, c.tid, g, S, E);
                if (c.bid >= 128) gemv8(c, (c.bid - 128) * NWAVES + c.wave, (c.G - 128) * NWAVES, H + (size_t)MP * D_MODEL, D_MODEL, D_MODEL, WTup, D_MODEL, N_UP, StBf16Up{Y + (size_t)MP * N_UP});
            } else if (sp == 6) {
                ffnact_phase(p, c, l, ws, outp);
            } else if (sp == 7) {
                pg8::Gemm g{ACT, WTdn, MP, D_MODEL, D_FF, D_FF, D_FF}; S.init(g, G, c.bid);
                pg8::EpiBf16 E{T, D_MODEL, c.lds};
                pg8::gemm_phase<pg8::EpiBf16, false>(c.lds, c.tid, g, S, E);
                gemv8(c, c.gw, c.NGW, ACT + (size_t)MP * D_FF, D_FF, D_FF, WTdn, D_FF, D_MODEL, StBf16{T + (size_t)MP * D_MODEL, D_MODEL});
            } else {
                const bool lastl = (l == DEPTH - 1);
                rownorm_phase(c, nullptr, XB, XS, T, ng + 3 * D_MODEL, mod, 5, yp, lastl ? (bf16*)nullptr : XB, ys, lastl ? nullptr : p.norm_g() + (size_t)(l + 1) * 4 * D_MODEL, modb + (size_t)(l + 1) * NB * N_MOD * D_MODEL, 0, 1, H);
            }
        }
        if (it + 1 < ph_hi) xcd_barrier((unsigned*)(ws + WS_CTL), bst, (unsigned)G_);
    }
}

extern "C" void kernel_launch(void* const* d_in, const int* in_sizes, int n_in, void* d_out, int out_size, void* d_ws, size_t ws_size, hipStream_t stream) {
    static int grid = 0;
    if (grid == 0) {
        if (n_in != 25 || (size_t)out_size != O_END || ws_size < WS_END) { fprintf(stderr, "kernel_launch: unexpected sizes n_in %d out %d (want %zu) ws %zu (want %zu)\n", n_in, out_size, (size_t)O_END, ws_size, (size_t)WS_END); grid = -1; return; }
        int dev = 0, cus = 0, per_cu = 0;
        hipGetDevice(&dev); hipDeviceGetAttribute(&cus, hipDeviceAttributeMultiprocessorCount, dev);
        if (hipFuncSetAttribute((const void*)mk_fwd, hipFuncAttributeMaxDynamicSharedMemorySize, LDS_BYTES) != hipSuccess) { fprintf(stderr, "kernel_launch: hipFuncSetAttribute failed\n"); grid = -1; return; }
        hipOccupancyMaxActiveBlocksPerMultiprocessor(&per_cu, (const void*)mk_fwd, NTHREADS, LDS_BYTES);
        if (per_cu < 1) { fprintf(stderr, "kernel_launch: occupancy query says %d blocks per CU\n", per_cu); grid = -1; return; }
        grid = cus;
    }
    if (grid < 0) return;
    (void)hipMemsetAsync((char*)d_ws + WS_CTL, 0, 16384, stream);
    Params p{};
    const float** pp = &p.x_prompt;
    for (int i = 0; i < 25; ++i) pp[i] = (const float*)d_in[i];
    p.out = (float*)d_out; p.ws = (unsigned char*)d_ws;
    for (int g = 0; g < 3; ++g) { const int dil = (g == 0) ? 1 : (g == 1 ? 4 : 16);
        for (int n = 0; n <= 128; ++n) { const int dist = n * dil; int bucket;
            if (dist < 16) bucket = dist; else { const int large = 16 + (int)(std::log((double)dist / 16.0) / std::log(2048.0 / 16.0) * 16.0); bucket = large < 31 ? large : 31; }
            p.tab.b[g][n] = (unsigned char)bucket; } }
#if MK_PER_PHASE
    for (int ph = 0; ph < N_PHASES; ++ph) { p.ph_lo = ph; p.ph_hi = ph + 1; hipLaunchKernelGGL(mk_fwd, dim3(grid), dim3(NTHREADS), LDS_BYTES, stream, p); }
#else
    p.ph_lo = 0; p.ph_hi = N_PHASES; p.rp = PROBE_RP; p.rc = PROBE_RC;
    void* args[] = {&p};
    hipError_t e = hipLaunchCooperativeKernel((const void*)mk_fwd, dim3(grid), dim3(NTHREADS), args, LDS_BYTES, stream);
    if (e != hipSuccess) fprintf(stderr, "kernel_launch: cooperative launch failed: %s\n", hipGetErrorString(e));
#endif
}
```

```cpp
#include <hip/hip_runtime.h>
#include <cstdint>
#include <cstdio>
#include <cmath>

#ifndef PROBE_RP
#define PROBE_RP 0
#define PROBE_RC 0
#endif
#ifndef MK_PER_PHASE
#define MK_PER_PHASE 0
#endif

#define LAS __attribute__((address_space(3)))
#define GAS __attribute__((address_space(1)))

namespace pg8 {
typedef unsigned short bf16_t;
typedef short bf16x8 __attribute__((ext_vector_type(8)));
typedef float f32x4 __attribute__((ext_vector_type(4)));
typedef unsigned u32x4 __attribute__((ext_vector_type(4)));
typedef unsigned u32x2 __attribute__((ext_vector_type(2)));
constexpr int BM = 256, BK = 64, HALF = 128, HTB = HALF * BK * 2, STAGE_BYTES = 8 * HTB, NXCD = 8, WGM = 8;

__host__ __device__ __forceinline__ int lds_byte(int r, int c) { const int st = (r >> 4) * 2 + (c >> 5), rr = r & 15, cc = c & 31, ob = rr * 64 + cc * 2; return st * 1024 + (ob ^ (((ob >> 9) & 1) << 5)); }
__host__ __device__ __forceinline__ void stage_rc(int b, int& R, int& C) { const int st = b / 1024, sb = b % 1024, swz = sb ^ (((sb >> 9) & 1) << 5); R = (st >> 1) * 16 + swz / 64; C = (st & 1) * 32 + (swz % 64) / 2; }
__host__ __device__ __forceinline__ int perm32(int rho) { const int n = rho >> 4, i = rho & 15; return 8 * (i >> 2) + 4 * n + (i & 3); }

struct Unit { int pm, pn, seg, nt; const char* a; const char* b; };
struct Gemm { const bf16_t* A; const bf16_t* Bt; int M, N, K, lda, ldb; };

__device__ __forceinline__ void tile_of(int wgid, int nM, int nN, int& pm, int& pn) {
    const int nwg = nM * nN; { const int q = nwg / NXCD, r = nwg % NXCD, xcd = wgid % NXCD, off = wgid / NXCD; wgid = (xcd < r ? xcd * (q + 1) : r * (q + 1) + (xcd - r) * q) + off; }
    const int nig = WGM * nN, gid = wgid / nig, fm = gid * WGM, gsz = (nM - fm) < WGM ? (nM - fm) : WGM;
    pm = fm + ((wgid % nig) % gsz); pn = (wgid % nig) / gsz;
}
struct StaticOrder {
    int nM, nN, nwg, G, c, nt; const char* A; const char* B; size_t tA, tB;
    __device__ void init(const Gemm& g, int G_, int c_) { nM = g.M / BM; nN = g.N / BM; nwg = nM * nN; G = G_; c = c_; nt = g.K / BK; A = (const char*)g.A; B = (const char*)g.Bt; tA = (size_t)BM * g.lda * 2; tB = (size_t)BM * g.ldb * 2; }
    __device__ bool next(int i, Unit& u) const {
        const long L = (long)i * G + c; if (L >= nwg) return false;
        tile_of((int)L, nM, nN, u.pm, u.pn); u.seg = 0; u.nt = nt; u.a = A + (size_t)u.pm * tA; u.b = B + (size_t)u.pn * tB; return true;
    }
};
struct SegOrder {
    int pm, pn; const char* A; const char* B; size_t tA, tB;
    __device__ void init(const Gemm& g, int c_) { tile_of(c_, g.M / BM, g.N / BM, pm, pn); A = (const char*)g.A; B = (const char*)g.Bt; tA = (size_t)BM * g.lda * 2; tB = (size_t)BM * g.ldb * 2; }
    __device__ bool next(int i, Unit& u) const {
        if (i >= 3) return false;
        u.pm = pm; u.pn = pn; u.seg = i; u.nt = (i == 2) ? 4 : 8; u.a = A + (size_t)pm * tA + (size_t)i * 1024; u.b = B + (size_t)pn * tB + (size_t)i * 1024; return true;
    }
};

__device__ __forceinline__ unsigned cvt_pk_bf16(float lo, float hi) { unsigned r; asm volatile("v_cvt_pk_bf16_f32 %0, %1, %2" : "=v"(r) : "v"(lo), "v"(hi)); return r; }
__device__ __forceinline__ float bf_lo(unsigned w) { return __uint_as_float(w << 16); }
__device__ __forceinline__ float bf_hi(unsigned w) { return __uint_as_float(w & 0xffff0000u); }

constexpr int EPI_LDS_OFF = 131072 + 2048;
struct EpiBf16 {
    static constexpr bool PERM = true, KEEP_ACC = false;
    bf16_t* O; int ldc; LAS unsigned char* lds;
    __device__ __forceinline__ void operator()(const f32x4 (&acc)[2][2][4][2], const Unit& u, int wr, int wc, int fr, int fq) const {
        LAS unsigned char* sc = lds + EPI_LDS_OFF + (wr * 4 + wc) * 1280;
        const int lane = fq * 16 + fr, lr = lane >> 2, ls = lane & 3;
        volatile LAS u32x4* wp = (volatile LAS u32x4*)(sc + fr * 80 + fq * 16);
        const volatile LAS u32x4* rp = (const volatile LAS u32x4*)(sc + lr * 80 + ls * 16);
        const int row0 = u.pm * BM + wr * 64 + lr, col0 = u.pn * BM + wc * 32 + 8 * ls;
#pragma unroll
        for (int ai = 0; ai < 2; ++ai)
#pragma unroll
            for (int m = 0; m < 4; ++m) { bf16_t* rowp = O + (size_t)(row0 + ai * HALF + m * 16) * ldc + col0;
#pragma unroll
                for (int bj = 0; bj < 2; ++bj) { const f32x4 v0 = acc[ai][bj][m][0], v1 = acc[ai][bj][m][1];
                    u32x4 w; w.x = cvt_pk_bf16(v0[0], v0[1]); w.y = cvt_pk_bf16(v0[2], v0[3]); w.z = cvt_pk_bf16(v1[0], v1[1]); w.w = cvt_pk_bf16(v1[2], v1[3]);
                    *wp = w; const u32x4 t = *rp;
                    *(u32x4*)(rowp + bj * HALF) = t; } }
    }
};
struct EpiF32 {
    static constexpr bool PERM = false, KEEP_ACC = false;
    float* C; int ldc;
    __device__ __forceinline__ void operator()(const f32x4 (&acc)[2][2][4][2], const Unit& u, int wr, int wc, int fr, int fq) const {
        const int row0 = u.pm * BM + wr * 64 + fr, col0 = u.pn * BM + wc * 32 + 4 * fq;
#pragma unroll
        for (int ai = 0; ai < 2; ++ai)
#pragma unroll
            for (int m = 0; m < 4; ++m) { float* rowp = C + (size_t)(row0 + ai * HALF + m * 16) * ldc + col0;
#pragma unroll
                for (int bj = 0; bj < 2; ++bj)
#pragma unroll
                    for (int n = 0; n < 2; ++n) *(f32x4*)(rowp + bj * HALF + n * 16) = acc[ai][bj][m][n]; }
    }
};
struct EpiGate {
    static constexpr bool PERM = true, KEEP_ACC = true;
    const bf16_t* gl0; int ldg; bf16_t* MG; LAS unsigned char* lds;
    __device__ __forceinline__ void operator()(f32x4 (&acc)[2][2][4][2], const Unit& u, int wr, int wc, int fr, int fq) const {
        const int seg = u.seg, lane = fq * 16 + fr, lr = lane >> 2, ls = lane & 3;
        LAS unsigned char* sc = lds + EPI_LDS_OFF + (wr * 4 + wc) * 1280;
        volatile LAS u32x4* pm_ = (volatile LAS u32x4*)(sc + lr * 80 + ls * 16);
        volatile LAS u32x4* pa_ = (volatile LAS u32x4*)(sc + fr * 80 + fq * 16);
        const int rowL = u.pm * BM + wr * 64 + lr, colL = u.pn * BM + wc * 32 + 8 * ls;
        const bf16_t* gn = gl0 + 2048 * seg;
        const bf16_t* gd = gl0 + 2048 * (seg < 2 ? seg + 1 : seg);
#pragma unroll
        for (int ai = 0; ai < 2; ++ai) {
            u32x4 gw[4][2], hw[4][2];
#pragma unroll
            for (int m = 0; m < 4; ++m)
#pragma unroll
                for (int bj = 0; bj < 2; ++bj) { const size_t o = (size_t)(rowL + ai * HALF + m * 16) * ldg + colL + bj * HALF;
                    gw[m][bj] = *(const u32x4*)(gn + o); hw[m][bj] = *(const u32x4*)(gd + o); }
#pragma unroll
            for (int m = 0; m < 4; ++m)
#pragma unroll
                for (int bj = 0; bj < 2; ++bj) {
                    *pm_ = gw[m][bj]; const u32x4 g4 = *pa_;
                    *pm_ = hw[m][bj]; const u32x4 h4 = *pa_;
                    float g[8], h[8];
                    g[0] = bf_lo(g4.x); g[1] = bf_hi(g4.x); g[2] = bf_lo(g4.y); g[3] = bf_hi(g4.y); g[4] = bf_lo(g4.z); g[5] = bf_hi(g4.z); g[6] = bf_lo(g4.w); g[7] = bf_hi(g4.w);
                    h[0] = bf_lo(h4.x); h[1] = bf_hi(h4.x); h[2] = bf_lo(h4.y); h[3] = bf_hi(h4.y); h[4] = bf_lo(h4.z); h[5] = bf_hi(h4.z); h[6] = bf_lo(h4.w); h[7] = bf_hi(h4.w);
                    float v[8];
#pragma unroll
                    for (int j = 0; j < 8; ++j) { const float num = (seg < 2) ? (1.0f + __expf(-h[j])) : 1.0f;
                        v[j] = acc[ai][bj][m][j >> 2][j & 3] * num * __builtin_amdgcn_rcpf(1.0f + __expf(-g[j])); acc[ai][bj][m][j >> 2][j & 3] = v[j]; }
                    if (seg == 2) { u32x4 w; w.x = cvt_pk_bf16(v[0], v[1]); w.y = cvt_pk_bf16(v[2], v[3]); w.z = cvt_pk_bf16(v[4], v[5]); w.w = cvt_pk_bf16(v[6], v[7]);
                        *pa_ = w; const u32x4 t = *pm_;
                        *(u32x4*)(MG + (size_t)(rowL + ai * HALF + m * 16) * 2048 + colL + bj * HALF) = t; } }
        }
    }
};

template <class Epi, bool ALIGN_EPI, class Sched>
__device__ __forceinline__ void gemm_phase(LAS unsigned char* lds, const int tid, const Gemm g, const Sched& S, const Epi& E) {
    const int wid = __builtin_amdgcn_readfirstlane(tid >> 6), lane = tid & 63, wr = wid >> 2, wc = wid & 3, fr = lane & 15, fq = lane >> 4;
    unsigned voffA[2], voffB[2];
#pragma unroll
    for (int i = 0; i < 2; ++i) { int R, C; stage_rc(tid * 16 + i * 8192, R, C); const int Rb = Epi::PERM ? ((R & ~31) + perm32(R & 31)) : R;
        voffA[i] = (unsigned)(R * g.lda + C) * 2u; voffB[i] = (unsigned)(Rb * g.ldb + C) * 2u; }
    const size_t kstep = (size_t)(BK * 2);
    const size_t hstepA = (size_t)HALF * g.lda * 2, hstepB = (size_t)HALF * g.ldb * 2;
    const unsigned ldsw = (unsigned)wid * 1024u;
    const int aoff = lds_byte(wr * 64 + fr, fq * 8), boff = lds_byte(wc * 32 + fr, fq * 8);
#define PG8_SA(b, h) (((b) * 2 + (h)) * HTB)
#define PG8_SB(b, h) ((4 + (b) * 2 + (h)) * HTB)
#define PG8_STAGE(bufoff, gbase, voff) do { _Pragma("unroll") for (int _i = 0; _i < 2; ++_i) \
        __builtin_amdgcn_global_load_lds((const unsigned*)((const char*)(gbase) + (voff)[_i]), (LAS unsigned*)(lds + (bufoff) + ldsw + _i * 8192), 16, 0, 0); } while (0)
#define PG8_LDA(dst, b, h) do { _Pragma("unroll") for (int m = 0; m < 4; ++m) _Pragma("unroll") for (int k = 0; k < 2; ++k) dst[m][k] = *(const LAS bf16x8*)(lds + PG8_SA(b, h) + aoff + m * 2048 + k * 1024); } while (0)
#define PG8_LDB(dst, b, h) do { _Pragma("unroll") for (int n = 0; n < 2; ++n) _Pragma("unroll") for (int k = 0; k < 2; ++k) dst[n][k] = *(const LAS bf16x8*)(lds + PG8_SB(b, h) + boff + n * 2048 + k * 1024); } while (0)
#define PG8_MMA(ai, bj, At, Bt) do { __builtin_amdgcn_s_setprio(1); _Pragma("unroll") for (int m = 0; m < 4; ++m) _Pragma("unroll") for (int n = 0; n < 2; ++n) _Pragma("unroll") for (int k = 0; k < 2; ++k) \
        acc[ai][bj][m][n] = __builtin_amdgcn_mfma_f32_16x16x32_bf16(Bt[n][k], At[m][k], acc[ai][bj][m][n], 0, 0, 0); __builtin_amdgcn_s_setprio(0); } while (0)
#define PG8_WAIT_V(n) asm volatile("s_waitcnt vmcnt(" #n ")" ::: "memory")
#define PG8_WAIT_L(n) asm volatile("s_waitcnt lgkmcnt(" #n ")" ::: "memory")
#define PG8_BAR __builtin_amdgcn_s_barrier()
#define PG8_SCHED __builtin_amdgcn_sched_barrier(0)
    Unit cur, nxt; int ui = 0;
    if (!S.next(0, cur)) return;
    f32x4 acc[2][2][4][2];
#pragma unroll
    for (int a = 0; a < 2; ++a)
#pragma unroll
        for (int b = 0; b < 2; ++b)
#pragma unroll
            for (int m = 0; m < 4; ++m)
#pragma unroll
                for (int n = 0; n < 2; ++n) acc[a][b][m][n] = (f32x4){0.f, 0.f, 0.f, 0.f};
    bf16x8 At[4][2], B0[2][2], B1[2][2];
    const char* cA = cur.a; const char* cB = cur.b;
    PG8_STAGE(PG8_SB(0, 0), cB, voffB); PG8_STAGE(PG8_SB(0, 1), cB + hstepB, voffB); PG8_STAGE(PG8_SA(0, 0), cA, voffA); PG8_STAGE(PG8_SA(0, 1), cA + hstepA, voffA);
    if (wr == 1) PG8_BAR;
    PG8_WAIT_V(2); PG8_BAR;
    PG8_STAGE(PG8_SB(1, 0), cB + kstep, voffB); PG8_STAGE(PG8_SA(1, 0), cA + kstep, voffA); PG8_STAGE(PG8_SB(1, 1), cB + hstepB + kstep, voffB);
    PG8_WAIT_V(6); PG8_BAR;
    for (;;) {
        const bool has_next = S.next(ui + 1, nxt);
        const char* nA = has_next ? nxt.a : cA; const char* nB = has_next ? nxt.b : cB;
        const int nt = cur.nt;
        for (int t = 0; t < nt; t += 2) {
            const bool last = (t == nt - 2);
            const char* a1 = cA + (size_t)(t + 1) * kstep;
            const char* a2 = last ? nA : cA + (size_t)(t + 2) * kstep; const char* b2 = last ? nB : cB + (size_t)(t + 2) * kstep;
            const char* a3 = a2 + kstep; const char* b3 = b2 + kstep;
            PG8_LDB(B0, 0, 0); PG8_LDB(B1, 0, 1); PG8_SCHED; PG8_LDA(At, 0, 0); PG8_STAGE(PG8_SA(1, 1), a1 + hstepA, voffA);
            PG8_WAIT_V(8); PG8_WAIT_L(0); PG8_BAR; PG8_MMA(0, 0, At, B0); PG8_MMA(0, 1, At, B1); PG8_BAR; PG8_SCHED;
            PG8_LDA(At, 0, 1); PG8_STAGE(PG8_SB(0, 0), b2, voffB); PG8_STAGE(PG8_SB(0, 1), b2 + hstepB, voffB); PG8_STAGE(PG8_SA(0, 0), a2, voffA);
            PG8_WAIT_V(8); PG8_WAIT_L(0); PG8_BAR; PG8_MMA(1, 0, At, B0); PG8_MMA(1, 1, At, B1); PG8_BAR; PG8_SCHED;
            PG8_LDB(B0, 1, 0); PG8_LDB(B1, 1, 1); PG8_SCHED; PG8_LDA(At, 1, 0); PG8_STAGE(PG8_SA(0, 1), a2 + hstepA, voffA);
            PG8_WAIT_V(8); PG8_WAIT_L(0); PG8_BAR; PG8_MMA(0, 0, At, B0); PG8_MMA(0, 1, At, B1); PG8_BAR; PG8_SCHED;
            PG8_LDA(At, 1, 1); PG8_STAGE(PG8_SB(1, 0), b3, voffB); PG8_STAGE(PG8_SB(1, 1), b3 + hstepB, voffB); PG8_STAGE(PG8_SA(1, 0), a3, voffA);
            PG8_WAIT_V(8); PG8_WAIT_L(0); PG8_BAR; PG8_MMA(1, 0, At, B0); PG8_MMA(1, 1, At, B1); PG8_BAR; PG8_SCHED;
        }
        if constexpr (ALIGN_EPI) { if (wr == 0) PG8_BAR; }
        E(acc, cur, wr, wc, fr, fq);
        if (!has_next) break;
        if constexpr (!Epi::KEEP_ACC) {
#pragma unroll
        for (int a = 0; a < 2; ++a)
#pragma unroll
            for (int b = 0; b < 2; ++b)
#pragma unroll
                for (int m = 0; m < 4; ++m)
#pragma unroll
                    for (int n = 0; n < 2; ++n) acc[a][b][m][n] = (f32x4){0.f, 0.f, 0.f, 0.f};
        }
        cur = nxt; cA = nA; cB = nB; ++ui;
        if constexpr (ALIGN_EPI) { if (wr == 1) PG8_BAR; }
    }
    PG8_WAIT_V(0);
    if constexpr (!ALIGN_EPI) { if (wr == 0) PG8_BAR; }
    PG8_BAR;
#undef PG8_SA
#undef PG8_SB
#undef PG8_STAGE
#undef PG8_LDA
#undef PG8_LDB
#undef PG8_MMA
#undef PG8_WAIT_V
#undef PG8_WAIT_L
#undef PG8_BAR
#undef PG8_SCHED
}
}

typedef unsigned short bf16;
typedef unsigned v4u __attribute__((ext_vector_type(4)));
typedef unsigned v2u __attribute__((ext_vector_type(2)));
typedef float f32x4 __attribute__((ext_vector_type(4)));

constexpr int D_MODEL = 2048, BATCH = 2, SEQ = 4096, DEPTH = 2, DEC_BATCH = 8;
constexpr int MP = BATCH * SEQ, MT = MP + DEC_BATCH, NB = BATCH + DEC_BATCH;
constexpr int N_IN = 10496, D_FF = 5632, N_UP = 2 * D_FF, N_MOD = 6, K_BR = 1280;
constexpr int OFF_Q = 0, OFF_K = 768, OFF_V = 1536, OFF_P = 2304, OFF_GB = 2816, OFF_GC = 3328, OFF_HC = 3840, OFF_GL = 4352;
constexpr float EPS = 1e-6f;
constexpr int NWAVES = 8, NTHREADS = 512;
constexpr int LDS_BYTES = 147456;

constexpr size_t al256(size_t x) { return (x + 255) & ~(size_t)255; }
constexpr size_t WS_CTL = 0, CTL_BYTES = 1u << 20;
constexpr size_t SZ_WTIN = (size_t)N_IN * D_MODEL * 2, SZ_WTBR = (size_t)D_MODEL * K_BR * 2, SZ_WTO = (size_t)D_MODEL * D_MODEL * 2, SZ_WTUP = (size_t)N_UP * D_MODEL * 2, SZ_WTDN = (size_t)D_MODEL * D_FF * 2;
constexpr size_t WS_WTIN = WS_CTL + CTL_BYTES;
constexpr size_t WS_WTBR = WS_WTIN + DEPTH * SZ_WTIN;
constexpr size_t WS_WTO = WS_WTBR + DEPTH * SZ_WTBR;
constexpr size_t WS_WTUP = WS_WTO + DEPTH * SZ_WTO;
constexpr size_t WS_WTDN = WS_WTUP + DEPTH * SZ_WTUP;
constexpr size_t WS_MOD = WS_WTDN + DEPTH * SZ_WTDN;
constexpr size_t WS_BIAS = WS_MOD + al256((size_t)DEPTH * NB * N_MOD * D_MODEL * 4);
constexpr size_t WS_H = WS_BIAS + 8192;
constexpr size_t WS_Y = WS_H + al256((size_t)MT * D_MODEL * 2);
constexpr size_t WS_A2 = WS_Y + al256((size_t)MT * N_UP * 2);
constexpr size_t WS_T = WS_A2 + al256((size_t)MT * K_BR * 2);
constexpr size_t WS_MG = WS_T + al256((size_t)MT * D_MODEL * 4);
constexpr size_t WS_ACT = WS_MG + al256((size_t)MT * D_MODEL * 2);
constexpr size_t WS_XS = WS_ACT + al256((size_t)MT * D_FF * 2);
constexpr size_t WS_OG = WS_XS + al256((size_t)DEC_BATCH * D_MODEL * 4);
constexpr size_t WS_LSE = WS_OG + al256((size_t)MT * 768 * 2);
constexpr size_t WS_XB = WS_LSE + al256((size_t)MT * 12 * 4);
constexpr size_t WS_PM = WS_XB + al256((size_t)MP * D_MODEL * 2);
constexpr size_t WS_END = WS_PM + al256((size_t)8 * DEPTH * NB * N_MOD * D_MODEL * 4);

struct BucketTab { unsigned char b[3][132]; unsigned pad; };
struct Params {
    const float *x_prompt, *x_sample, *c_prompt, *c_sample, *c128, *c512, *c2048, *state_pool, *state_conv, *state_ffn, *rel_bias, *norm_g, *w_ada, *b_ada, *w_in,
        *w_attn_br, *w_pool_grp, *pool_scale, *w_pool_br, *conv_w, *w_conv_br, *w_o, *w_up, *ffn_conv_w, *w_down;
    float* out; unsigned char* ws;
    BucketTab tab;
    int ph_lo, ph_hi, rp, rc;
};

constexpr int PARAM_LDS_OFF = 131072 + 1024;
struct PL {
    LAS const unsigned char* b;
    __device__ __forceinline__ const float* ldp(int off) const { const LAS unsigned* q = (const LAS unsigned*)(b + off);
        const unsigned lo = __builtin_amdgcn_readfirstlane(q[0]), hi = __builtin_amdgcn_readfirstlane(q[1]); return (const float*)(const GAS float*)(((unsigned long long)hi << 32) | lo); }
#define PL_F(name) __device__ __forceinline__ const float* name() const { return ldp((int)offsetof(Params, name)); }
    PL_F(x_prompt)
    PL_F(x_sample)
    PL_F(c_prompt)
    PL_F(c_sample)
    PL_F(c128)
    PL_F(c512)
    PL_F(c2048)
    PL_F(state_pool)
    PL_F(state_conv)
    PL_F(state_ffn)
    PL_F(rel_bias)
    PL_F(norm_g)
    PL_F(w_ada)
    PL_F(b_ada)
    PL_F(w_in)
    PL_F(w_attn_br)
    PL_F(w_pool_grp)
    PL_F(pool_scale)
    PL_F(w_pool_br)
    PL_F(conv_w)
    PL_F(w_conv_br)
    PL_F(w_o)
    PL_F(w_up)
    PL_F(ffn_conv_w)
    PL_F(w_down)
#undef PL_F
    __device__ __forceinline__ int bucket(int g, int n) const { return (int)b[(int)offsetof(Params, tab) + g * 132 + n]; }
};
constexpr size_t O_YP = 0, O_YS = O_YP + (size_t)MP * D_MODEL;
constexpr size_t O_KVP0 = O_YS + (size_t)DEC_BATCH * D_MODEL;
constexpr size_t O_KVP1 = O_KVP0 + (size_t)DEPTH * BATCH * 128 * 512;
constexpr size_t O_KVP2 = O_KVP1 + (size_t)DEPTH * BATCH * 512 * 512;
constexpr size_t O_POOLP = O_KVP2 + (size_t)DEPTH * BATCH * 2048 * 512;
constexpr size_t O_CONVP = O_POOLP + (size_t)DEPTH * BATCH * 15 * 512;
constexpr size_t O_FFNP = O_CONVP + (size_t)DEPTH * BATCH * 2 * 512;
constexpr size_t O_KVS0 = O_FFNP + (size_t)DEPTH * BATCH * 2 * N_UP;
constexpr size_t O_KVS1 = O_KVS0 + (size_t)DEPTH * DEC_BATCH * 512;
constexpr size_t O_KVS2 = O_KVS1 + (size_t)DEPTH * DEC_BATCH * 512;
constexpr size_t O_POOLS = O_KVS2 + (size_t)DEPTH * DEC_BATCH * 512;
constexpr size_t O_CONVS = O_POOLS + (size_t)DEPTH * DEC_BATCH * 15 * 512;
constexpr size_t O_FFNS = O_CONVS + (size_t)DEPTH * DEC_BATCH * 2 * 512;
constexpr size_t O_END = O_FFNS + (size_t)DEPTH * DEC_BATCH * 2 * N_UP;

__device__ __forceinline__ float bf2f(bf16 v) { return __uint_as_float((unsigned)v << 16); }
__device__ __forceinline__ unsigned f2bf(float f) { unsigned u = __float_as_uint(f); return (u + 0x7fffu + ((u >> 16) & 1u)) >> 16; }
__device__ __forceinline__ unsigned pk2(float lo, float hi) { return pg8::cvt_pk_bf16(lo, hi); }
__device__ __forceinline__ float blo(unsigned w) { return __uint_as_float(w << 16); }
__device__ __forceinline__ float bhi(unsigned w) { return __uint_as_float(w & 0xffff0000u); }
__device__ __forceinline__ void unpack8(const v4u w, float (&f)[8]) { f[0] = blo(w.x); f[1] = bhi(w.x); f[2] = blo(w.y); f[3] = bhi(w.y); f[4] = blo(w.z); f[5] = bhi(w.z); f[6] = blo(w.w); f[7] = bhi(w.w); }
__device__ __forceinline__ v4u pack8(const float (&f)[8]) { v4u w; w.x = pk2(f[0], f[1]); w.y = pk2(f[2], f[3]); w.z = pk2(f[4], f[5]); w.w = pk2(f[6], f[7]); return w; }
typedef __bf16 bf16x2_t __attribute__((ext_vector_type(2)));
__device__ __forceinline__ float dot2bf(unsigned a, unsigned b, float acc) { return __builtin_amdgcn_fdot2_f32_bf16(__builtin_bit_cast(bf16x2_t, a), __builtin_bit_cast(bf16x2_t, b), acc, false); }
__device__ __forceinline__ float dot8(const v4u a, const v4u b, float acc) { acc = dot2bf(a.x, b.x, acc); acc = dot2bf(a.y, b.y, acc); acc = dot2bf(a.z, b.z, acc); return dot2bf(a.w, b.w, acc); }
__device__ __forceinline__ float wave_sum(float v) {
#pragma unroll
    for (int o = 1; o < 64; o <<= 1) v += __shfl_xor(v, o);
    return v; }
__device__ __forceinline__ float wave_max(float v) {
#pragma unroll
    for (int o = 1; o < 64; o <<= 1) v = fmaxf(v, __shfl_xor(v, o));
    return v; }
#define LDS_FENCE() asm volatile("s_waitcnt lgkmcnt(0)" ::: "memory")
__device__ __forceinline__ float reduce8(const float (&a)[8], int lane) {
    float b[4], c2[2], d;
    const bool h32 = (lane & 32) != 0, h16 = (lane & 16) != 0, h8 = (lane & 8) != 0;
#pragma unroll
    for (int i = 0; i < 4; ++i) { const float snd = h32 ? a[i] : a[i + 4], kep = h32 ? a[i + 4] : a[i]; b[i] = kep + __shfl_xor(snd, 32); }
#pragma unroll
    for (int i = 0; i < 2; ++i) { const float snd = h16 ? b[i] : b[i + 2], kep = h16 ? b[i + 2] : b[i]; c2[i] = kep + __shfl_xor(snd, 16); }
    { const float snd = h8 ? c2[0] : c2[1], kep = h8 ? c2[1] : c2[0]; d = kep + __shfl_xor(snd, 8); }
    d += __shfl_xor(d, 4); d += __shfl_xor(d, 2); d += __shfl_xor(d, 1);
    return d;
}
__device__ __forceinline__ float sigmoidf_(float x) { float e = __expf(-x); asm volatile("" : "+v"(e)); return __builtin_amdgcn_rcpf(1.0f + e); }
__device__ __forceinline__ float gelu_tanh(float x) {
    const float z = x * fmaf(-0.1029432396f, x * x, -2.3022081981f);
    return x * __builtin_amdgcn_rcpf(1.0f + __builtin_amdgcn_exp2f(z)); }

__device__ __forceinline__ int up_perm(int n) { return n < D_FF ? 256 * (n >> 7) + (n & 127) : 256 * ((n - D_FF) >> 7) + 128 + ((n - D_FF) & 127); }
__device__ __forceinline__ int up_unperm(int r) { return ((r >> 7) & 1) * D_FF + 128 * (r >> 8) + (r & 127); }
template <int N> __device__ __forceinline__ float dpp_ror(float x) { return __int_as_float(__builtin_amdgcn_mov_dpp(__float_as_int(x), 0x120 + N, 0xf, 0xf, false)); }
struct EpiFfn {
    static constexpr bool PERM = true, KEEP_ACC = false;
    bf16* ACT; bf16* UP; const float* fw;
    __device__ __forceinline__ void operator()(const f32x4 (&acc)[2][2][4][2], const pg8::Unit& u, int wr, int wc, int fr, int fq) const {
        const int row0 = u.pm * 256 + wr * 64 + fr, j0 = u.pn * 128 + wc * 32 + 8 * fq;
        v2u keep[2][4];
        f32x4 wga[2][3], wva[2][3];
#pragma unroll
        for (int n = 0; n < 2; ++n)
#pragma unroll
            for (int t = 0; t < 3; ++t) { wga[n][t] = *(const f32x4*)(fw + (size_t)t * N_UP + j0 + 4 * n); wva[n][t] = *(const f32x4*)(fw + (size_t)t * N_UP + D_FF + j0 + 4 * n); }
#pragma unroll
        for (int n = 0; n < 2; ++n) {
            const int j = j0 + 4 * n;
            f32x4 wg[3], wv[3];
#pragma unroll
            for (int t = 0; t < 3; ++t) { wg[t] = wga[n][t]; wv[t] = wva[n][t]; }
#pragma unroll
            for (int ai = 0; ai < 2; ++ai) {
                f32x4 g1p = (f32x4){0.f, 0.f, 0.f, 0.f}, g2p = g1p, v1p = g1p, v2p = g1p;
#pragma unroll
                for (int m = 0; m < 4; ++m) {
                    const f32x4 g = acc[ai][0][m][n], v = acc[ai][1][m][n];
                    f32x4 g1, g2, v1, v2, o;
#pragma unroll
                    for (int e = 0; e < 4; ++e) { g1[e] = dpp_ror<1>(g[e]); g2[e] = dpp_ror<2>(g[e]); v1[e] = dpp_ror<1>(v[e]); v2[e] = dpp_ror<2>(v[e]); }
                    {
                        const f32x4 pg1 = fr >= 1 ? g1 : g1p, pg2 = fr >= 2 ? g2 : g2p, pv1 = fr >= 1 ? v1 : v1p, pv2 = fr >= 2 ? v2 : v2p;
                        const f32x4 cg = wg[2] * g + wg[1] * pg1 + wg[0] * pg2, cv = wv[2] * v + wv[1] * pv1 + wv[0] * pv2;
                        const f32x4 z = cg * (cg * cg * (-0.1029432396f) + (-2.3022081981f));
                        f32x4 d;
#pragma unroll
                        for (int e = 0; e < 4; ++e) d[e] = __builtin_amdgcn_exp2f(z[e]);
                        d = d + 1.0f;
#pragma unroll
                        for (int e = 0; e < 4; ++e) d[e] = __builtin_amdgcn_rcpf(d[e]);
                        o = cg * d * cv; }
                    const int r = row0 + 128 * ai + 16 * m;
                    v2u pk; pk.x = pg8::cvt_pk_bf16(o[0], o[1]); pk.y = pg8::cvt_pk_bf16(o[2], o[3]);
                    if (n == 0) keep[ai][m] = pk;
                    else if (!(m == 0 && fr < 2)) { v4u w; w.x = keep[ai][m].x; w.y = keep[ai][m].y; w.z = pk.x; w.w = pk.y; *(v4u*)(ACT + (size_t)r * D_FF + j0) = w; }
                    if ((m == 0 && fr < 2) || (m == 3 && fr >= 14)) {
                        v2u rg, rv; rg.x = pg8::cvt_pk_bf16(g[0], g[1]); rg.y = pg8::cvt_pk_bf16(g[2], g[3]); rv.x = pg8::cvt_pk_bf16(v[0], v[1]); rv.y = pg8::cvt_pk_bf16(v[2], v[3]);
                        *(v2u*)(UP + (size_t)r * N_UP + j) = rg; *(v2u*)(UP + (size_t)r * N_UP + D_FF + j) = rv; }
                    g1p = g1; g2p = g2; v1p = v1; v2p = v2;
                }
            }
        }
    }
};
struct StBf16Up { bf16* O; __device__ __forceinline__ void operator()(int n, int r, float v) const { O[(size_t)r * N_UP + up_unperm(n)] = (bf16)f2bf(v); } };

struct Ctx {
    LAS unsigned char* lds; int tid, lane, wave, gw, NGW, bid, G;
};
struct StBf16 { bf16* O; int ld; __device__ __forceinline__ void operator()(int n, int r, float v) const { O[(size_t)r * ld + n] = (bf16)f2bf(v); } };
struct StF32 { float* O; int ld; __device__ __forceinline__ void operator()(int n, int r, float v) const { O[(size_t)r * ld + n] = v; } };

struct TItem { const float* src; bf16* dst; int N, ldt; };
__device__ __forceinline__ TItem titem_desc(const PL p, unsigned char* ws, int it) {
    constexpr int I_IN = (D_MODEL / 64) * (N_IN / 32), I_O = (D_MODEL / 64) * (D_MODEL / 32), I_UP = (D_MODEL / 64) * (N_UP / 32), I_DN = (D_FF / 64) * (D_MODEL / 32),
                  I_CV = (512 / 64) * (D_MODEL / 32), I_AT = (256 / 64) * (D_MODEL / 32), I_L = I_IN + I_O + I_UP + I_DN + I_CV + I_AT;
    const int l = it / I_L; int r = it % I_L;
    const float* W; bf16* WT; int N, ldt, koff = 0, k0, n0;
    if (r < I_IN) { W = p.w_in() + (size_t)l * D_MODEL * N_IN; N = N_IN; WT = (bf16*)(ws + WS_WTIN + l * SZ_WTIN); ldt = D_MODEL; k0 = 64 * (r / (N_IN / 32)); n0 = 32 * (r % (N_IN / 32)); }
    else if ((r -= I_IN) < I_O) { W = p.w_o() + (size_t)l * D_MODEL * D_MODEL; N = D_MODEL; WT = (bf16*)(ws + WS_WTO + l * SZ_WTO); ldt = D_MODEL; k0 = 64 * (r / (D_MODEL / 32)); n0 = 32 * (r % (D_MODEL / 32)); }
    else if ((r -= I_O) < I_UP) { W = p.w_up() + (size_t)l * D_MODEL * N_UP; N = N_UP; WT = (bf16*)(ws + WS_WTUP + l * SZ_WTUP); ldt = D_MODEL; k0 = 64 * (r / (N_UP / 32)); n0 = 32 * (r % (N_UP / 32)); }
    else if ((r -= I_UP) < I_DN) { W = p.w_down() + (size_t)l * D_FF * D_MODEL; N = D_MODEL; WT = (bf16*)(ws + WS_WTDN + l * SZ_WTDN); ldt = D_FF; k0 = 64 * (r / (D_MODEL / 32)); n0 = 32 * (r % (D_MODEL / 32)); }
    else if ((r -= I_DN) < I_CV) { W = p.w_conv_br() + (size_t)l * 512 * D_MODEL; N = D_MODEL; WT = (bf16*)(ws + WS_WTBR + l * SZ_WTBR); ldt = K_BR; koff = 512; k0 = 64 * (r / (D_MODEL / 32)); n0 = 32 * (r % (D_MODEL / 32)); }
    else { r -= I_CV; W = p.w_attn_br() + (size_t)l * 256 * D_MODEL; N = D_MODEL; WT = (bf16*)(ws + WS_WTBR + l * SZ_WTBR); ldt = K_BR; koff = 1024; k0 = 64 * (r / (D_MODEL / 32)); n0 = 32 * (r % (D_MODEL / 32)); }
    const int nrow = (N == N_UP) ? up_perm(n0) : n0;
    TItem t; t.src = W + (size_t)k0 * N + n0; t.dst = WT + (size_t)nrow * ldt + koff + k0; t.N = N; t.ldt = ldt; return t;
}
constexpr int N_TITEMS = DEPTH * ((D_MODEL / 64) * (N_IN / 32) + (D_MODEL / 64) * (D_MODEL / 32) + (D_MODEL / 64) * (N_UP / 32) + (D_FF / 64) * (D_MODEL / 32) + (512 / 64) * (D_MODEL / 32) + (256 / 64) * (D_MODEL / 32));
__device__ __forceinline__ void titem_load(const TItem& t, int lane, f32x4 (&v)[8]) {
    const float* s = t.src + (size_t)(8 * (lane >> 3)) * t.N + 4 * (lane & 7);
#pragma unroll
    for (int j = 0; j < 8; ++j) v[j] = __builtin_nontemporal_load((const f32x4*)(s + (size_t)j * t.N));
}
__device__ __forceinline__ void titem_store(const TItem& t, int lane, const f32x4 (&v)[8]) {
    bf16* d = t.dst + (size_t)(4 * (lane & 7)) * t.ldt + 8 * (lane >> 3);
#pragma unroll
    for (int e = 0; e < 4; ++e) { v4u o; o.x = pk2(v[0][e], v[1][e]); o.y = pk2(v[2][e], v[3][e]); o.z = pk2(v[4][e], v[5][e]); o.w = pk2(v[6][e], v[7][e]);
        *(v4u*)(d + (size_t)e * t.ldt) = o; }
}

__device__ __forceinline__ void phase_A(const PL p, const Ctx& c, unsigned char* ws) {
    { LAS float* scs = (LAS float*)c.lds;
      LAS float* red = (LAS float*)(c.lds + 10240);
      float* PM = (float*)(ws + WS_PM);
      for (int item = c.bid; item < DEPTH * 48 * 8; item += c.G) {
        const int layer = item / 384, ksl = (item % 384) / 48, cg = item % 48, c4 = c.lane & 7, ks = c.lane >> 3, k0 = ksl * 256;
        __syncthreads();
        for (int i = c.tid; i < NB * 256; i += NTHREADS) { const int b = i >> 8, k = k0 + (i & 255);
            const float v = (b < BATCH) ? p.c_prompt()[b * D_MODEL + k] : p.c_sample()[(b - BATCH) * D_MODEL + k]; scs[i] = v / (1.0f + __expf(-v)); }
        __syncthreads();
        const float* W = p.w_ada() + (size_t)layer * D_MODEL * (N_MOD * D_MODEL) + (size_t)(k0 + ks) * (N_MOD * D_MODEL) + cg * 256 + c.wave * 32 + 4 * c4;
        f32x4 acc[NB];
#pragma unroll
        for (int b = 0; b < NB; ++b) acc[b] = (f32x4){0.f, 0.f, 0.f, 0.f};
        for (int i0 = 0; i0 < 32; i0 += 8) {
            f32x4 w[8];
#pragma unroll
            for (int i = 0; i < 8; ++i) w[i] = __builtin_nontemporal_load((const f32x4*)(W + (size_t)((i0 + i) * 8) * (N_MOD * D_MODEL)));
#pragma unroll
            for (int i = 0; i < 8; ++i) { const int kk = (i0 + i) * 8 + ks;
#pragma unroll
                for (int b = 0; b < NB; ++b) acc[b] = acc[b] + w[i] * scs[b * 256 + kk]; }
        }
#pragma unroll
        for (int b = 0; b < NB; ++b) *(LAS f32x4*)(red + ((c.wave * 8 + ks) * NB + b) * 32 + 4 * c4) = acc[b];
        __syncthreads();
        for (int i = c.tid; i < NB * 256; i += NTHREADS) { const int b = i >> 8, col = i & 255, w = col >> 5, cc = col & 31; float sm = 0.f;
#pragma unroll
            for (int k8 = 0; k8 < 8; ++k8) sm += red[((w * 8 + k8) * NB + b) * 32 + cc];
            PM[((size_t)(ksl * DEPTH + layer) * NB + b) * (N_MOD * D_MODEL) + cg * 256 + col] = sm; }
      }
      __syncthreads(); }
    for (int it = c.gw; it < N_TITEMS; it += c.NGW) {
        const TItem t0 = titem_desc(p, ws, it);
        f32x4 v0[8];
        titem_load(t0, c.lane, v0);
        titem_store(t0, c.lane, v0);
    }
    for (int it = c.gw; it < DEPTH * 2048; it += c.NGW) {
        const int l = it / 2048, kc = (it % 2048) / 32, nb = it % 32, k0 = kc * 8, g = k0 >> 7, c0 = k0 & 127, n = nb * 64 + c.lane;
        const float* wpg = p.w_pool_grp() + (size_t)l * 4 * 128 * 128 + (size_t)(g * 128 + c0) * 128;
        const float* ps = p.pool_scale() + (size_t)l * 512 + g * 128;
        const float* wpb = p.w_pool_br() + (size_t)l * 512 * D_MODEL + (size_t)(g * 128) * D_MODEL + n;
        float acc[8];
#pragma unroll
        for (int j = 0; j < 8; ++j) acc[j] = 0.f;
        for (int e0 = 0; e0 < 128; e0 += 16) {
            float wb[16];
#pragma unroll
            for (int u = 0; u < 16; ++u) wb[u] = wpb[(size_t)(e0 + u) * D_MODEL];
#pragma unroll
            for (int u = 0; u < 16; ++u) { const float w = wb[u] * ps[e0 + u];
#pragma unroll
                for (int j = 0; j < 8; ++j) acc[j] = fmaf(wpg[j * 128 + e0 + u], w, acc[j]); }
        }
        *(v4u*)((bf16*)(ws + WS_WTBR + l * SZ_WTBR) + (size_t)n * K_BR + k0) = pack8(acc);
    }
    if (c.bid == 0) { float* biasT = (float*)(ws + WS_BIAS);
        for (int i = c.tid; i < 3 * 4 * 129; i += NTHREADS) { const int g = i / (4 * 129), h = (i / 129) % 4, n = i % 129; biasT[i] = p.rel_bias()[p.bucket(g, n) * 12 + g * 4 + h]; } }
}

__device__ __forceinline__ void modsum_phase(const PL p, const Ctx& c, unsigned char* ws) {
    const float* PM = (const float*)(ws + WS_PM); float* mod = (float*)(ws + WS_MOD);
    constexpr int NTOT = DEPTH * NB * N_MOD * D_MODEL;
    for (int i = c.gw * 64 + c.lane; i < NTOT; i += c.NGW * 64) {
        float v[8];
#pragma unroll
        for (int s8 = 0; s8 < 8; ++s8) v[s8] = PM[(size_t)s8 * NTOT + i];
        const int layer = i / (NB * N_MOD * D_MODEL), col = i % (N_MOD * D_MODEL);
        mod[i] = ((v[0] + v[1]) + (v[2] + v[3])) + ((v[4] + v[5]) + (v[6] + v[7])) + p.b_ada()[(size_t)layer * (N_MOD * D_MODEL) + col]; }
}

__device__ __forceinline__ void rownorm_phase(const Ctx& c, const float* xin_p, const bf16* xin_pb, const float* xin_s, const bf16* y, const float* g_post, const float* mod_y, int i_gate,
                                              float* xout_p, bf16* xout_pb, float* xout_s, const float* g_pre, const float* mod_h, int i_shift, int i_scale, bf16* H) {
    for (int row = c.gw; row < MT; row += c.NGW) {
        int lane_ = c.lane; asm volatile("" : "+v"(lane_));
        const int cr = row < MP ? row / SEQ : BATCH + (row - MP);
        f32x4 x[8];
        if (row < MP && xin_pb) {
            const v2u* xb = (const v2u*)(xin_pb + (size_t)row * D_MODEL) + lane_;
#pragma unroll
            for (int j = 0; j < 8; ++j) { const v2u w = xb[64 * j]; x[j] = (f32x4){blo(w.x), bhi(w.x), blo(w.y), bhi(w.y)}; }
        } else {
            const f32x4* xr = (const f32x4*)(row < MP ? xin_p + (size_t)row * D_MODEL : xin_s + (size_t)(row - MP) * D_MODEL) + lane_;
#pragma unroll
            for (int j = 0; j < 8; ++j) x[j] = xr[64 * j];
        }
        if (y) {
            const v2u* yr = (const v2u*)(y + (size_t)row * D_MODEL) + lane_;
            const f32x4* gp = (const f32x4*)g_post + lane_;
            const f32x4* gt = (const f32x4*)(mod_y + (size_t)cr * (N_MOD * D_MODEL) + (size_t)i_gate * D_MODEL) + lane_;
            f32x4 v[8], gpv[8], gtv[8]; float ss = 0.f;
#pragma unroll
            for (int j = 0; j < 8; ++j) { const v2u yw = yr[64 * j]; v[j] = (f32x4){blo(yw.x), bhi(yw.x), blo(yw.y), bhi(yw.y)}; gpv[j] = gp[64 * j]; gtv[j] = gt[64 * j]; }
#pragma unroll
            for (int j = 0; j < 8; ++j) ss += (v[j].x * v[j].x + v[j].y * v[j].y) + (v[j].z * v[j].z + v[j].w * v[j].w);
            const float rstd = 1.0f / sqrtf(wave_sum(ss) * (1.0f / D_MODEL) + EPS);
#pragma unroll
            for (int j = 0; j < 8; ++j) x[j] = x[j] + gtv[j] * (v[j] * rstd * gpv[j]);
        }
        asm volatile("" ::: "memory");
        f32x4 g2[8], shv[8], slv[8];
        if (g_pre) {
            const f32x4* gp = (const f32x4*)g_pre + lane_;
            const f32x4* sh = (const f32x4*)(mod_h + (size_t)cr * (N_MOD * D_MODEL) + (size_t)i_shift * D_MODEL) + lane_;
            const f32x4* sl = (const f32x4*)(mod_h + (size_t)cr * (N_MOD * D_MODEL) + (size_t)i_scale * D_MODEL) + lane_;
#pragma unroll
            for (int j = 0; j < 8; ++j) { g2[j] = gp[64 * j]; shv[j] = sh[64 * j]; slv[j] = sl[64 * j]; }
        }
        if (y) {
            if (row < MP && xout_pb) { v2u* xo = (v2u*)(xout_pb + (size_t)row * D_MODEL) + lane_;
#pragma unroll
                for (int j = 0; j < 8; ++j) { v2u w; w.x = pk2(x[j].x, x[j].y); w.y = pk2(x[j].z, x[j].w); xo[64 * j] = w;
                    x[j] = (f32x4){blo(w.x), bhi(w.x), blo(w.y), bhi(w.y)}; }
            } else { f32x4* xo = (f32x4*)(row < MP ? xout_p + (size_t)row * D_MODEL : xout_s + (size_t)(row - MP) * D_MODEL) + lane_;
#pragma unroll
                for (int j = 0; j < 8; ++j) xo[64 * j] = x[j]; } }
        if (g_pre) {
            float ss = 0.f;
#pragma unroll
            for (int j = 0; j < 8; ++j) ss += (x[j].x * x[j].x + x[j].y * x[j].y) + (x[j].z * x[j].z + x[j].w * x[j].w);
            const float rstd = 1.0f / sqrtf(wave_sum(ss) * (1.0f / D_MODEL) + EPS);
            v2u* ho = (v2u*)(H + (size_t)row * D_MODEL) + lane_;
#pragma unroll
            for (int j = 0; j < 8; ++j) { const f32x4 hv = x[j] * rstd * g2[j] * (slv[j] + 1.0f) + shv[j]; v2u w; w.x = pk2(hv.x, hv.y); w.y = pk2(hv.z, hv.w); ho[64 * j] = w; }
        }
    }
}

template <class F>
__device__ __forceinline__ void gemv8(const Ctx& c, int fw, int nfw, const bf16* A8, int lda, int K, const bf16* Bt, int ldb, int N, const F f) {
    const int kc = K / 8;
    for (int n = fw; n < N; n += nfw) {
        float acc[8];
#pragma unroll
        for (int r = 0; r < 8; ++r) acc[r] = 0.f;
        const bf16* br = Bt + (size_t)n * ldb;
        for (int ch = c.lane; ch < kc; ch += 64) { const v4u b = *(const v4u*)(br + ch * 8);
            v4u a[8];
#pragma unroll
            for (int r = 0; r < 8; ++r) a[r] = *(const v4u*)(A8 + (size_t)r * lda + ch * 8);
#pragma unroll
            for (int r = 0; r < 8; ++r) acc[r] = dot8(a[r], b, acc[r]); }
        const float v = reduce8(acc, c.lane);
        if ((c.lane & 7) == 0) f(n, ((c.lane >> 5) & 1) * 4 + ((c.lane >> 4) & 1) * 2 + ((c.lane >> 3) & 1), v);
    }
}
__device__ __forceinline__ void gemv8_branch(const Ctx& c, const bf16* A8  , const bf16* Bt  , const bf16* Y1s  , bf16* MGs) {
    constexpr int kc = K_BR / 8;
    for (int n = c.gw; n < D_MODEL; n += c.NGW) {
        float acc[3][8];
#pragma unroll
        for (int s = 0; s < 3; ++s)
#pragma unroll
            for (int r = 0; r < 8; ++r) acc[s][r] = 0.f;
        const bf16* br = Bt + (size_t)n * K_BR;
#pragma unroll
        for (int s = 0; s < 3; ++s) { const int ch = c.lane + 64 * s;
            if (ch < kc) { const v4u b = *(const v4u*)(br + ch * 8);
                v4u a[8];
#pragma unroll
                for (int r = 0; r < 8; ++r) a[r] = *(const v4u*)(A8 + (size_t)r * K_BR + ch * 8);
#pragma unroll
                for (int r = 0; r < 8; ++r) acc[s][r] = dot8(a[r], b, acc[s][r]); } }
        const float v0 = reduce8(acc[0], c.lane), v1 = reduce8(acc[1], c.lane), v2 = reduce8(acc[2], c.lane);
        const int rr = ((c.lane >> 5) & 1) * 4 + ((c.lane >> 4) & 1) * 2 + ((c.lane >> 3) & 1);
        if ((c.lane & 7) == 0) { const bf16* gl = Y1s + (size_t)rr * N_IN + OFF_GL + n;
            const float m = sigmoidf_(bf2f(gl[0])) * v0 + sigmoidf_(bf2f(gl[D_MODEL])) * v1 + sigmoidf_(bf2f(gl[2 * D_MODEL])) * v2;
            MGs[(size_t)rr * D_MODEL + n] = (bf16)f2bf(m); }
    }
}

typedef short bf16x8_t __attribute__((ext_vector_type(8)));
typedef short s16x4_t __attribute__((ext_vector_type(4)));
typedef float f32x4_t __attribute__((ext_vector_type(4)));
constexpr int AT_RS = 160;
constexpr int AT_K = 0, AT_V = 256 * AT_RS, AT_BIAS = 2 * 256 * AT_RS;
__device__ __forceinline__ s16x4_t vtr(const LAS unsigned char* p) { return __builtin_bit_cast(s16x4_t, __builtin_amdgcn_ds_read_tr16_b64_v4i16((LAS s16x4_t*)p)); }
struct AttnPre { v4u kv[4], vv[4]; float bias; bf16x8_t q0, q1; };
__device__ __forceinline__ void attn_prefetch(const bf16* Y, const float* biasT, int item, int tid, AttnPre& P) {
    const int lane = tid & 63, w = __builtin_amdgcn_readfirstlane(tid >> 6);
    const int b = item / 384, g = (item / 128) % 3, h = (item / 32) % 4, idx = item % 32;
    const int dil = (g == 0) ? 1 : (g == 1 ? 4 : 16), nbc = 32 / dil, r = idx / nbc, i0 = (idx % nbc) * 128;
    const int co = g * 256 + h * 64;
    const bf16* Yb = Y + (size_t)b * SEQ * N_IN;
#pragma unroll
    for (int ps = 0; ps < 4; ++ps) { const int rowl = ps * 64 + (tid >> 3), ch = tid & 7, ik = i0 - 128 + rowl;
        P.kv[ps] = (v4u){0u, 0u, 0u, 0u}; P.vv[ps] = (v4u){0u, 0u, 0u, 0u};
        if (ik >= 0) { const bf16* src = Yb + (size_t)(ik * dil + r) * N_IN + co + ch * 8; P.kv[ps] = *(const v4u*)(src + OFF_K); P.vv[ps] = *(const v4u*)(src + OFF_V); } }
    P.bias = (tid < 129) ? biasT[(g * 4 + h) * 129 + tid] : 0.f;
    const int a = lane & 15, quad = lane >> 4, tq = (i0 + 16 * w + a) * dil + r;
    const bf16* qp = Yb + (size_t)tq * N_IN + OFF_Q + co + 8 * quad; P.q0 = *(const bf16x8_t*)qp; P.q1 = *(const bf16x8_t*)(qp + 32);
}
__device__ __forceinline__ void attn_block_items(const bf16* Y, const float* biasT, bf16* OG, float* LSE, int first, int step, int nitems, LAS unsigned char* lds, int tid) {
  if (first >= nitems) return;
  AttnPre P;
  attn_prefetch(Y, biasT, first, tid, P);
  for (int item = first;;) {
    const int lane = tid & 63, w = __builtin_amdgcn_readfirstlane(tid >> 6);
    const int b = item / 384, g = (item / 128) % 3, h = (item / 32) % 4, idx = item % 32;
    const int dil = (g == 0) ? 1 : (g == 1 ? 4 : 16), nbc = 32 / dil, r = idx / nbc, i0 = (idx % nbc) * 128;
#pragma unroll
    for (int ps = 0; ps < 4; ++ps) { const int rowl = ps * 64 + (tid >> 3), ch = tid & 7;
        *(LAS v4u*)(lds + AT_K + rowl * AT_RS + ch * 16) = P.kv[ps]; *(LAS v4u*)(lds + AT_V + rowl * AT_RS + ch * 16) = P.vv[ps]; }
    if (tid < 129) ((LAS float*)(lds + AT_BIAS))[tid] = P.bias;
    bf16x8_t qf[2]; qf[0] = P.q0; qf[1] = P.q1;
    __syncthreads();
    const int nxt = item + step;
    if (nxt < nitems) attn_prefetch(Y, biasT, nxt, tid, P);
    const int a = lane & 15, quad = lane >> 4;
    const int tq = (i0 + 16 * w + a) * dil + r;
    f32x4_t sc[9];
#pragma unroll
    for (int j = 0; j < 9; ++j) { const LAS unsigned char* kp = lds + AT_K + (16 * w + 16 * j + a) * AT_RS + 16 * quad;
        const bf16x8_t k0 = *(const LAS bf16x8_t*)kp, k1 = *(const LAS bf16x8_t*)(kp + 64);
        f32x4_t acc = (f32x4_t){0.f, 0.f, 0.f, 0.f};
        acc = __builtin_amdgcn_mfma_f32_16x16x32_bf16(k0, qf[0], acc, 0, 0, 0);
        acc = __builtin_amdgcn_mfma_f32_16x16x32_bf16(k1, qf[1], acc, 0, 0, 0);
        sc[j] = acc; }
    const LAS float* sb = (const LAS float*)(lds + AT_BIAS);
    float m = -1e30f;
#pragma unroll
    for (int j = 0; j < 9; ++j)
#pragma unroll
        for (int e = 0; e < 4; ++e) { const int kk = 16 * j + 4 * quad + e, dist = a + 128 - kk, ik = i0 + 16 * w - 128 + kk;
            const bool valid = (dist >= 0) && (dist <= 128) && (ik >= 0);
            const int dc = dist < 0 ? 0 : (dist > 128 ? 128 : dist);
            const float s = valid ? sc[j][e] * 0.125f + sb[dc] : -1e30f;
            sc[j][e] = s; m = fmaxf(m, s); }
    m = fmaxf(m, __shfl_xor(m, 16)); m = fmaxf(m, __shfl_xor(m, 32));
    float l = 0.f;
#pragma unroll
    for (int j = 0; j < 9; ++j)
#pragma unroll
        for (int e = 0; e < 4; ++e) { const float pv = (sc[j][e] > -1e29f) ? __expf(sc[j][e] - m) : 0.f; sc[j][e] = pv; l += pv; }
    l += __shfl_xor(l, 16); l += __shfl_xor(l, 32);
    f32x4_t oacc[4];
#pragma unroll
    for (int dt = 0; dt < 4; ++dt) oacc[dt] = (f32x4_t){0.f, 0.f, 0.f, 0.f};
    const LAS unsigned char* vbase = lds + AT_V + (16 * w + 4 * quad + ((lane & 15) >> 2)) * AT_RS + 8 * (lane & 3);
#pragma unroll
    for (int ss = 0; ss < 5; ++ss) {
        v4u pw; pw.x = pk2(sc[2 * ss][0], sc[2 * ss][1]); pw.y = pk2(sc[2 * ss][2], sc[2 * ss][3]);
        if (ss < 4) { pw.z = pk2(sc[2 * ss + 1][0], sc[2 * ss + 1][1]); pw.w = pk2(sc[2 * ss + 1][2], sc[2 * ss + 1][3]); } else { pw.z = 0u; pw.w = 0u; }
        const bf16x8_t pb = __builtin_bit_cast(bf16x8_t, pw);
#pragma unroll
        for (int dt = 0; dt < 4; ++dt) {
            const s16x4_t lo = vtr(vbase + (32 * ss) * AT_RS + 32 * dt);
            s16x4_t hi = (s16x4_t){0, 0, 0, 0};
            if (ss < 4) hi = vtr(vbase + (32 * ss + 16) * AT_RS + 32 * dt);
            bf16x8_t va; va[0] = lo[0]; va[1] = lo[1]; va[2] = lo[2]; va[3] = lo[3]; va[4] = hi[0]; va[5] = hi[1]; va[6] = hi[2]; va[7] = hi[3];
            oacc[dt] = __builtin_amdgcn_mfma_f32_16x16x32_bf16(va, pb, oacc[dt], 0, 0, 0);
        }
    }
    const float il = 1.0f / l;
    bf16* op = OG + ((size_t)(b * SEQ + tq) * 3 + g) * 256 + h * 64 + 4 * quad;
#pragma unroll
    for (int dt = 0; dt < 4; ++dt) { v2u o; o.x = pk2(oacc[dt][0] * il, oacc[dt][1] * il); o.y = pk2(oacc[dt][2] * il, oacc[dt][3] * il); *(v2u*)(op + 16 * dt) = o; }
    if (quad == 0) LSE[((size_t)(b * SEQ + tq) * 3 + g) * 4 + h] = m + __logf(l);
    __syncthreads();
    if (nxt >= nitems) break;
    item = nxt;
  }
}
__device__ __forceinline__ void attn_combine_phase(const Ctx& c, const bf16* OG, const float* LSE, bf16* A2) {
    const int h = c.lane >> 4, d4 = (c.lane & 15) * 4;
    for (int tok = c.gw; tok < MT; tok += c.NGW) {
        const float l0 = LSE[(size_t)tok * 12 + h], l1 = LSE[(size_t)tok * 12 + 4 + h], l2 = LSE[(size_t)tok * 12 + 8 + h];
        const float mm = fmaxf(l0, fmaxf(l1, l2));
        const float w0 = __expf(l0 - mm), w1 = __expf(l1 - mm), w2 = __expf(l2 - mm), iw = 1.0f / (w0 + w1 + w2);
        const bf16* op = OG + (size_t)tok * 768 + h * 64 + d4;
        const v2u a0 = *(const v2u*)op, a1 = *(const v2u*)(op + 256), a2 = *(const v2u*)(op + 512);
        v2u o;
        o.x = pk2((w0 * blo(a0.x) + w1 * blo(a1.x) + w2 * blo(a2.x)) * iw, (w0 * bhi(a0.x) + w1 * bhi(a1.x) + w2 * bhi(a2.x)) * iw);
        o.y = pk2((w0 * blo(a0.y) + w1 * blo(a1.y) + w2 * blo(a2.y)) * iw, (w0 * bhi(a0.y) + w1 * bhi(a1.y) + w2 * bhi(a2.y)) * iw);
        *(v2u*)(A2 + (size_t)tok * K_BR + 1024 + h * 64 + d4) = o;
    }
}
__device__ __forceinline__ void attn_sample_item(const PL p, const bf16* Y, const float* biasT, bf16* OG, float* LSE, int layer, int bs, int h, int g, LAS float* ps, int lane) {
    const int row = MP + bs;
    const int dil = (g == 0) ? 1 : (g == 1 ? 4 : 16), Lc = 128 * dil;
    const float* cache = (g == 0 ? p.c128() : (g == 1 ? p.c512() : p.c2048())) + (size_t)(layer * DEC_BATCH + bs) * Lc * 512;
    const int co = g * 256 + h * 64;
    float q[64];
    { const v4u* qp = (const v4u*)(Y + (size_t)row * N_IN + OFF_Q + co);
#pragma unroll
      for (int i = 0; i < 8; ++i) { float f[8]; unpack8(qp[i], f);
#pragma unroll
          for (int e = 0; e < 8; ++e) q[8 * i + e] = f[e]; } }
    float s[3];
#pragma unroll
    for (int j = 0; j < 3; ++j) { const int n = lane + 64 * j; s[j] = -1e30f;
        if (n <= 128) { float d = 0.f;
            if (n == 0) { const v4u* kp = (const v4u*)(Y + (size_t)row * N_IN + OFF_K + co);
#pragma unroll
                for (int i = 0; i < 8; ++i) { float f[8]; unpack8(kp[i], f);
#pragma unroll
                    for (int e = 0; e < 8; ++e) d = fmaf(q[8 * i + e], f[e], d); } }
            else { const f32x4* kp = (const f32x4*)(cache + (size_t)(Lc - n * dil) * 512 + h * 64);
#pragma unroll
                for (int i = 0; i < 16; ++i) { const f32x4 kv = kp[i]; d = fmaf(q[4 * i], kv.x, d); d = fmaf(q[4 * i + 1], kv.y, d); d = fmaf(q[4 * i + 2], kv.z, d); d = fmaf(q[4 * i + 3], kv.w, d); } }
            s[j] = d * 0.125f + biasT[(g * 4 + h) * 129 + n]; } }
    const float m = wave_max(fmaxf(s[0], fmaxf(s[1], s[2])));
    float pj[3], l = 0.f;
#pragma unroll
    for (int j = 0; j < 3; ++j) { pj[j] = (s[j] > -1e29f) ? __expf(s[j] - m) : 0.f; l += pj[j]; }
    l = wave_sum(l);
    LDS_FENCE();
#pragma unroll
    for (int j = 0; j < 3; ++j) ps[lane + 64 * j] = pj[j];
    LDS_FENCE();
    const int d4 = 4 * (lane & 15), kq = lane >> 4;
    f32x4 o = (f32x4){0.f, 0.f, 0.f, 0.f};
    const float* vb = cache + (size_t)Lc * 512 + 256 + h * 64 + d4;
#pragma unroll 8
    for (int i = 0; i < 32; ++i) { const int n = 4 * i + kq + 1; const f32x4 vv = *(const f32x4*)(vb - (long)n * dil * 512); o = o + vv * ps[n]; }
    if (kq == 0) { const v2u w = *(const v2u*)(Y + (size_t)row * N_IN + OFF_V + co + d4); const float p0 = ps[0];
        o.x = fmaf(p0, blo(w.x), o.x); o.y = fmaf(p0, bhi(w.x), o.y); o.z = fmaf(p0, blo(w.y), o.z); o.w = fmaf(p0, bhi(w.y), o.w); }
#pragma unroll
    for (int e = 0; e < 4; ++e) { float t = o[e]; t += __shfl_xor(t, 16); t += __shfl_xor(t, 32); o[e] = t; }
    const float il = 1.0f / l;
    if (kq == 0) { v2u w; w.x = pk2(o.x * il, o.y * il); w.y = pk2(o.z * il, o.w * il); *(v2u*)(OG + ((size_t)row * 3 + g) * 256 + h * 64 + d4) = w; }
    if (lane == 0) LSE[((size_t)row * 3 + g) * 4 + h] = m + __logf(l);
    LDS_FENCE();
}
__device__ __forceinline__ void poolconv_row(const PL p, const bf16* Y, bf16* A2, int layer, int row, int lane) {
    const bf16* yr = Y + (size_t)row * N_IN;
    const int c0 = lane * 8, grp = lane >> 4, w = 2 << grp;
    const v4u curw = *(const v4u*)(yr + OFF_P + c0);
    const v4u gbw = *(const v4u*)(yr + OFF_GB + c0), gcw = *(const v4u*)(yr + OFF_GC + c0), hcw = *(const v4u*)(yr + OFF_HC + c0);
    const float* cw = p.conv_w() + (size_t)layer * 3 * 512 + c0;
    f32x4 cwv[3][2];
#pragma unroll
    for (int t = 0; t < 3; ++t) { cwv[t][0] = *(const f32x4*)(cw + t * 512); cwv[t][1] = *(const f32x4*)(cw + t * 512 + 4); }
    float s[8], cur[8], u1[8], u2[8], inv;
    if (row < MP) {
        const int t = row % SEQ, cnt = (t + 1 < w) ? (t + 1) : w;
        v4u ld[15];
#pragma unroll
        for (int i = 1; i < 16; ++i) { ld[i - 1] = (v4u){0u, 0u, 0u, 0u}; if (i < cnt) ld[i - 1] = *(const v4u*)(yr - (size_t)i * N_IN + OFF_P + c0); }
        const bf16* y1 = yr - (t >= 1 ? N_IN : 0); const bf16* y2 = yr - (t >= 2 ? 2 * N_IN : 0);
        const v4u g1 = *(const v4u*)(y1 + OFF_GC + c0), h1 = *(const v4u*)(y1 + OFF_HC + c0), g2 = *(const v4u*)(y2 + OFF_GC + c0), h2 = *(const v4u*)(y2 + OFF_HC + c0);
        const float k1 = t >= 1 ? 1.f : 0.f, k2 = t >= 2 ? 1.f : 0.f;
        unpack8(curw, cur);
#pragma unroll
        for (int j = 0; j < 8; ++j) s[j] = cur[j];
#pragma unroll
        for (int i = 1; i < 16; ++i) { float f[8]; unpack8(ld[i - 1], f);
#pragma unroll
            for (int j = 0; j < 8; ++j) s[j] += f[j]; }
        inv = 1.0f / (float)cnt;
        float a[8], b[8];
        unpack8(g1, a); unpack8(h1, b);
#pragma unroll
        for (int j = 0; j < 8; ++j) u1[j] = a[j] * b[j] * k1;
        unpack8(g2, a); unpack8(h2, b);
#pragma unroll
        for (int j = 0; j < 8; ++j) u2[j] = a[j] * b[j] * k2;
    } else {
        unpack8(curw, cur);
#pragma unroll
        for (int j = 0; j < 8; ++j) s[j] = cur[j];
        const float* st = p.state_pool() + (size_t)(layer * DEC_BATCH + (row - MP)) * 15 * 512 + c0;
        for (int i = 1; i < w; ++i) { const f32x4 a = *(const f32x4*)(st + (size_t)(15 - i) * 512), b = *(const f32x4*)(st + (size_t)(15 - i) * 512 + 4);
            s[0] += a.x; s[1] += a.y; s[2] += a.z; s[3] += a.w; s[4] += b.x; s[5] += b.y; s[6] += b.z; s[7] += b.w; }
        inv = 1.0f / (float)w;
        const float* sc = p.state_conv() + (size_t)(layer * DEC_BATCH + (row - MP)) * 2 * 512 + c0;
#pragma unroll
        for (int j = 0; j < 8; ++j) { u2[j] = sc[j]; u1[j] = sc[512 + j]; }
    }
    float pm[8], gb[8], gc[8], hc[8], cb[8];
#pragma unroll
    for (int j = 0; j < 8; ++j) pm[j] = s[j] * inv - cur[j];
    unpack8(gbw, gb); unpack8(gcw, gc); unpack8(hcw, hc);
#pragma unroll
    for (int j = 0; j < 8; ++j) { const float u0 = gc[j] * hc[j]; cb[j] = gb[j] * (u2[j] * cwv[0][j >> 2][j & 3] + u1[j] * cwv[1][j >> 2][j & 3] + u0 * cwv[2][j >> 2][j & 3]); }
    *(v4u*)(A2 + (size_t)row * K_BR + c0) = pack8(pm);
    *(v4u*)(A2 + (size_t)row * K_BR + 512 + c0) = pack8(cb);
}
__device__ __forceinline__ void poolconv_rows5(const PL p, const bf16* Y, bf16* A2, int layer, int r0, int nr, int lane) {
    const int c0 = lane * 8, grp = lane >> 4, w = 2 << grp;
    const float* cw = p.conv_w() + (size_t)layer * 3 * 512 + c0;
    f32x4 cwv[3][2];
#pragma unroll
    for (int t = 0; t < 3; ++t) { cwv[t][0] = *(const f32x4*)(cw + t * 512); cwv[t][1] = *(const f32x4*)(cw + t * 512 + 4); }
    v4u P[20], GC[7], HC[7], GB[5];
#pragma unroll
    for (int m = 0; m < 20; ++m) P[m] = (v4u){0u, 0u, 0u, 0u};
    const bf16* yb = Y + OFF_P + c0;
    if (grp == 3) {
#pragma unroll
        for (int m = 0; m < 8; ++m) { const int rr = r0 - 15 + m; P[m] = *(const v4u*)(yb + (size_t)(rr < 0 ? 0 : rr) * N_IN); } }
    if (grp >= 2) {
#pragma unroll
        for (int m = 8; m < 12; ++m) { const int rr = r0 - 15 + m; P[m] = *(const v4u*)(yb + (size_t)(rr < 0 ? 0 : rr) * N_IN); } }
    if (grp >= 1) {
#pragma unroll
        for (int m = 12; m < 14; ++m) { const int rr = r0 - 15 + m; P[m] = *(const v4u*)(yb + (size_t)(rr < 0 ? 0 : rr) * N_IN); } }
#pragma unroll
    for (int m = 14; m < 20; ++m) { const int rr = r0 - 15 + m; P[m] = *(const v4u*)(yb + (size_t)(rr < 0 ? 0 : rr) * N_IN); }
#pragma unroll
    for (int m = 0; m < 7; ++m) { const int rr = r0 - 2 + m; const bf16* yr = Y + (size_t)(rr < 0 ? 0 : rr) * N_IN + c0; GC[m] = *(const v4u*)(yr + OFF_GC); HC[m] = *(const v4u*)(yr + OFF_HC); }
#pragma unroll
    for (int q = 0; q < 5; ++q) GB[q] = *(const v4u*)(Y + (size_t)(r0 + q) * N_IN + OFF_GB + c0);
    v4u pmw[5];
    float s[8];
#pragma unroll
    for (int q = 0; q < 5; ++q) {
        const int t = (r0 + q) % SEQ, cnt = (t + 1 < w) ? (t + 1) : w;
        float cur[8]; unpack8(P[15 + q], cur);
        if (q == 0) {
#pragma unroll
            for (int j = 0; j < 8; ++j) s[j] = cur[j];
#pragma unroll
            for (int i = 1; i < 16; ++i) { float f[8]; unpack8(P[15 - i], f); const bool in = i < cnt;
#pragma unroll
                for (int j = 0; j < 8; ++j) s[j] += in ? f[j] : 0.f; }
        } else {
            const bool fresh = (t == 0), drop = (t >= w);
            float old[8];
#pragma unroll
            for (int j = 0; j < 8; ++j) old[j] = 0.f;
            { float f2[8], f4[8], f8[8], f16[8]; unpack8(P[13 + q], f2); unpack8(P[11 + q], f4); unpack8(P[7 + q], f8); unpack8(P[q - 1], f16);
#pragma unroll
              for (int j = 0; j < 8; ++j) old[j] = grp == 0 ? f2[j] : (grp == 1 ? f4[j] : (grp == 2 ? f8[j] : f16[j])); }
#pragma unroll
            for (int j = 0; j < 8; ++j) s[j] = fresh ? cur[j] : (s[j] + cur[j] - (drop ? old[j] : 0.f));
        }
        const float inv = 1.0f / (float)cnt;
        float pm[8];
#pragma unroll
        for (int j = 0; j < 8; ++j) pm[j] = s[j] * inv - cur[j];
        pmw[q] = pack8(pm);
    }
    v4u cbw[5];
    { float ua[8], ub[8], uc[8];
      { float a[8], b[8]; unpack8(GC[0], a); unpack8(HC[0], b);
#pragma unroll
        for (int j = 0; j < 8; ++j) ua[j] = a[j] * b[j];
        unpack8(GC[1], a); unpack8(HC[1], b);
#pragma unroll
        for (int j = 0; j < 8; ++j) ub[j] = a[j] * b[j]; }
#pragma unroll
      for (int q = 0; q < 5; ++q) {
          const int t = (r0 + q) % SEQ;
          float a[8], b[8], gb[8], cb[8]; unpack8(GC[q + 2], a); unpack8(HC[q + 2], b); unpack8(GB[q], gb);
          const float k1 = t >= 1 ? 1.f : 0.f, k2 = t >= 2 ? 1.f : 0.f;
#pragma unroll
          for (int j = 0; j < 8; ++j) { uc[j] = a[j] * b[j];
              cb[j] = gb[j] * ((ua[j] * k2) * cwv[0][j >> 2][j & 3] + (ub[j] * k1) * cwv[1][j >> 2][j & 3] + uc[j] * cwv[2][j >> 2][j & 3]); }
          cbw[q] = pack8(cb);
#pragma unroll
          for (int j = 0; j < 8; ++j) { ua[j] = ub[j]; ub[j] = uc[j]; }
      } }
#pragma unroll
    for (int q = 0; q < 5; ++q) if (q < nr) { *(v4u*)(A2 + (size_t)(r0 + q) * K_BR + c0) = pmw[q]; *(v4u*)(A2 + (size_t)(r0 + q) * K_BR + 512 + c0) = cbw[q]; }
}

__device__ __forceinline__ void mixer_phase(const PL p, const Ctx& c, int layer, unsigned char* ws, float* outp) {
    const bf16* Y = (const bf16*)(ws + WS_Y); bf16* A2 = (bf16*)(ws + WS_A2); const float* biasT = (const float*)(ws + WS_BIAS);
    LAS float* ps = (LAS float*)(c.lds + c.wave * 1024);
    float* out = outp;
    constexpr int NB0 = 32;
    if (c.bid < NB0) return;
    const int mb = c.bid - NB0, mG = c.G - NB0, mgw = mb * NWAVES + c.wave, mNGW = mG * NWAVES;
    const int gtid = mgw * 64 + c.lane, gsz = mNGW * 64;
    { constexpr int NQ = BATCH * (128 + 512 + 2048) * 64;
      for (int q0 = gtid; q0 < NQ; q0 += 4 * gsz) {
          v4u v[4]; float* dst[4];
#pragma unroll
          for (int u = 0; u < 4; ++u) { const int q = q0 + u * gsz; dst[u] = nullptr;
              if (q < NQ) { const int pidx = q >> 6, ch = q & 63, b = pidx / 2688, pp = pidx % 2688, g = pp < 128 ? 0 : (pp < 640 ? 1 : 2), j = pp - (g == 0 ? 0 : (g == 1 ? 128 : 640)), w = 128 << (2 * g);
                  v[u] = *(const v4u*)(Y + (size_t)(b * SEQ + SEQ - w + j) * N_IN + ((ch >> 5) ? OFF_V : OFF_K) + g * 256 + (ch & 31) * 8);
                  dst[u] = out + (g == 0 ? O_KVP0 : (g == 1 ? O_KVP1 : O_KVP2)) + (size_t)layer * (BATCH * w * 512) + ((size_t)(b * w + j) * 512 + ch * 8); } }
#pragma unroll
          for (int u = 0; u < 4; ++u) if (dst[u]) { float f[8]; unpack8(v[u], f); *(f32x4*)dst[u] = (f32x4){f[0], f[1], f[2], f[3]}; *(f32x4*)(dst[u] + 4) = (f32x4){f[4], f[5], f[6], f[7]}; } } }
    { constexpr int N0 = 3 * DEC_BATCH * 512, N1 = N0 + BATCH * 15 * 512, N2 = N1 + DEC_BATCH * 15 * 512, N3 = N2 + BATCH * 2 * 512, N4 = N3 + DEC_BATCH * 2 * 512;
      for (int i0 = gtid; i0 < N4; i0 += gsz) {
      int i = i0; float val = 0.f; float* dst = nullptr;
      if (i < N0) { const int g = i / (DEC_BATCH * 512), ii = i % (DEC_BATCH * 512), hd = ii & 255, kv = (ii >> 8) & 1, b = ii >> 9;
          val = bf2f(Y[(size_t)(MP + b) * N_IN + (kv ? OFF_V : OFF_K) + g * 256 + hd]); dst = out + (g == 0 ? O_KVS0 : (g == 1 ? O_KVS1 : O_KVS2)) + (size_t)layer * DEC_BATCH * 512 + ii; }
      else if (i < N1) { i -= N0; const int cc = i & 511, j = (i >> 9) % 15, b = (i >> 9) / 15;
          val = bf2f(Y[(size_t)(b * SEQ + SEQ - 15 + j) * N_IN + OFF_P + cc]); dst = out + O_POOLP + (size_t)layer * BATCH * 15 * 512 + i; }
      else if (i < N2) { i -= N1; const int cc = i & 511, j = (i >> 9) % 15, b = (i >> 9) / 15;
          val = (j < 14) ? p.state_pool()[((size_t)(layer * DEC_BATCH + b) * 15 + j + 1) * 512 + cc] : bf2f(Y[(size_t)(MP + b) * N_IN + OFF_P + cc]); dst = out + O_POOLS + (size_t)layer * DEC_BATCH * 15 * 512 + i; }
      else if (i < N3) { i -= N2; const int cc = i & 511, j = (i >> 9) & 1, b = i >> 10; const bf16* yr = Y + (size_t)(b * SEQ + SEQ - 2 + j) * N_IN;
          val = bf2f(yr[OFF_GC + cc]) * bf2f(yr[OFF_HC + cc]); dst = out + O_CONVP + (size_t)layer * BATCH * 2 * 512 + i; }
      else if (i < N4) { i -= N3; const int cc = i & 511, j = (i >> 9) & 1, b = i >> 10; const bf16* yr = Y + (size_t)(MP + b) * N_IN;
          val = (j == 0) ? p.state_conv()[((size_t)(layer * DEC_BATCH + b) * 2 + 1) * 512 + cc] : bf2f(yr[OFF_GC + cc]) * bf2f(yr[OFF_HC + cc]); dst = out + O_CONVS + (size_t)layer * DEC_BATCH * 2 * 512 + i; }
      if (dst) *dst = val; } }
    if (mG == 224) {
        poolconv_rows5(p, Y, A2, layer, mgw < 768 ? 4 * mgw : 3072 + 5 * (mgw - 768), mgw < 768 ? 4 : 5, c.lane);
        if (mgw < DEC_BATCH) poolconv_row(p, Y, A2, layer, MP + mgw, c.lane);
    } else {
        for (int row = mgw; row < MT; row += mNGW) poolconv_row(p, Y, A2, layer, row, c.lane);
    }
    if (c.wave == 0 && mb >= 96 && mb < 96 + DEC_BATCH * 12) { const int it = mb - 96; attn_sample_item(p, Y, biasT, (bf16*)(ws + WS_OG), (float*)(ws + WS_LSE), layer, it / 12, (it / 3) % 4, it % 3, ps, c.lane); }
    __syncthreads();
    attn_block_items(Y, biasT, (bf16*)(ws + WS_OG), (float*)(ws + WS_LSE), mb, mG, BATCH * 3 * 4 * 32, c.lds, c.tid);
}

__device__ __forceinline__ void ffnact_phase(const PL p, const Ctx& c, int layer, unsigned char* ws, float* outp) {
    const bf16* UP = (const bf16*)(ws + WS_Y); bf16* ACT = (bf16*)(ws + WS_ACT);
    const float* fw = p.ffn_conv_w() + (size_t)layer * 3 * N_UP;
    const int gtid = c.gw * 64 + c.lane, gsz = c.NGW * 64;
    constexpr int CH = D_FF / 8;
    for (int idx = gtid; idx < (MP / 32 + DEC_BATCH) * CH; idx += gsz) {
        const int ri = idx / CH, j0 = (idx % CH) * 8, row = ri < MP / 32 ? (ri >> 1) * 64 + (ri & 1) : MP + (ri - MP / 32);
        const bf16* r0 = UP + (size_t)row * N_UP + j0;
        const float* fwj = fw + j0;
        f32x4 wg[3][2], wv[3][2];
#pragma unroll
        for (int t = 0; t < 3; ++t)
#pragma unroll
            for (int h = 0; h < 2; ++h) { wg[t][h] = *(const f32x4*)(fwj + (size_t)t * N_UP + 4 * h); wv[t][h] = *(const f32x4*)(fwj + (size_t)t * N_UP + D_FF + 4 * h); }
        float g0[8], v0[8], g1[8], v1[8], g2[8], v2[8];
        unpack8(*(const v4u*)r0, g0); unpack8(*(const v4u*)(r0 + D_FF), v0);
        if (row < MP) { const int t = row % SEQ;
            const bf16* r1 = r0 - (t >= 1 ? N_UP : 0); const bf16* r2 = r0 - (t >= 2 ? 2 * N_UP : 0);
            const v4u a1 = *(const v4u*)r1, b1 = *(const v4u*)(r1 + D_FF), a2 = *(const v4u*)r2, b2 = *(const v4u*)(r2 + D_FF);
            const float k1 = t >= 1 ? 1.f : 0.f, k2 = t >= 2 ? 1.f : 0.f;
            unpack8(a1, g1); unpack8(b1, v1); unpack8(a2, g2); unpack8(b2, v2);
#pragma unroll
            for (int j = 0; j < 8; ++j) { g1[j] *= k1; v1[j] *= k1; g2[j] *= k2; v2[j] *= k2; }
        } else { const float* st = p.state_ffn() + (size_t)(layer * DEC_BATCH + (row - MP)) * 2 * N_UP + j0;
#pragma unroll
            for (int h = 0; h < 2; ++h) { const f32x4 x1 = *(const f32x4*)(st + N_UP + 4 * h), y1 = *(const f32x4*)(st + N_UP + D_FF + 4 * h), x2 = *(const f32x4*)(st + 4 * h), y2 = *(const f32x4*)(st + D_FF + 4 * h);
#pragma unroll
                for (int e = 0; e < 4; ++e) { g1[4 * h + e] = x1[e]; v1[4 * h + e] = y1[e]; g2[4 * h + e] = x2[e]; v2[4 * h + e] = y2[e]; } }
        }
        float o[8];
#pragma unroll
        for (int j = 0; j < 8; ++j) { const int h = j >> 2, e = j & 3;
            const float a = fmaf(g2[j], wg[0][h][e], fmaf(g1[j], wg[1][h][e], g0[j] * wg[2][h][e]));
            const float b = fmaf(v2[j], wv[0][h][e], fmaf(v1[j], wv[1][h][e], v0[j] * wv[2][h][e]));
            o[j] = gelu_tanh(a) * b; }
        *(v4u*)(ACT + (size_t)row * D_FF + j0) = pack8(o);
    }
    float* out = outp;
    for (int i = gtid; i < BATCH * 2 * N_UP; i += gsz) { const int cc = i % N_UP, j = (i / N_UP) & 1, b = i / (2 * N_UP);
        out[O_FFNP + (size_t)layer * BATCH * 2 * N_UP + i] = bf2f(UP[(size_t)(b * SEQ + SEQ - 2 + j) * N_UP + cc]); }
    for (int i = gtid; i < DEC_BATCH * 2 * N_UP; i += gsz) { const int cc = i % N_UP, j = (i / N_UP) & 1, b = i / (2 * N_UP);
        out[O_FFNS + (size_t)layer * DEC_BATCH * 2 * N_UP + i] = (j == 0) ? p.state_ffn()[((size_t)(layer * DEC_BATCH + b) * 2 + 1) * N_UP + cc] : bf2f(UP[(size_t)(MP + b) * N_UP + cc]); }
}


#define XB_TMO      128
#define XB_XCNT(j)  (256  + 64 * (j))
#define XB_XSUB(j)  (1280 + 64 * (j))
#define XB_XGEN(j)  (2304 + 64 * (j))
#define XB_TOP      3328
#define XB_TOPGEN   3392
#define XCD_BAR_WORDS 3456
#define XB_SPIN_CAP (1u << 22)
__device__ __forceinline__ unsigned xb_ld(unsigned* p)              { return __hip_atomic_load(p, __ATOMIC_RELAXED, __HIP_MEMORY_SCOPE_AGENT); }
__device__ __forceinline__ unsigned xb_add(unsigned* p, unsigned v) { return __hip_atomic_fetch_add(p, v, __ATOMIC_RELAXED, __HIP_MEMORY_SCOPE_AGENT); }
__device__ __forceinline__ unsigned xb_xcc_id() { return (unsigned)__builtin_amdgcn_s_getreg((3 << 11) | 20) & 0xFu; }
#define XB_SPIN(cond, bar) do { unsigned _sp = 0; while (cond) { __builtin_amdgcn_s_sleep(1); \
    if ((++_sp & 255u) == 0u) { if (xb_ld(&(bar)[XB_TMO])) break; if (_sp > XB_SPIN_CAP) { atomicAdd(&(bar)[XB_TMO], 1u); break; } } } } while (0)
__device__ __forceinline__ void xcd_barrier_complete(unsigned* bar, unsigned x, unsigned G, unsigned& nloc, unsigned& nx) {
    unsigned sum, cnt, mine, sp = 0u;
    for (;;) {
        sum = 0u; cnt = 0u; mine = 0u;
#pragma unroll
        for (unsigned j = 0; j < 16; ++j) { const unsigned c = xb_ld(&bar[XB_XCNT(j)]); sum += c; cnt += (c > 0u) ? 1u : 0u; mine = (j == x) ? c : mine; }
        if (sum == G) break;
        __builtin_amdgcn_s_sleep(1);
        if ((++sp & 255u) == 0u) { if (xb_ld(&bar[XB_TMO])) break; if (sp > XB_SPIN_CAP) { atomicAdd(&bar[XB_TMO], 1u); break; } }
    }
    nloc = mine > 0u ? mine : 1u; nx = cnt > 0u ? cnt : 1u;
}
__device__ __forceinline__ void xcd_barrier(unsigned* bar, volatile LAS unsigned* st, unsigned G) {
    asm volatile("s_waitcnt vmcnt(0)" ::: "memory");
    __syncthreads();
    if (threadIdx.x == 0) {
        const unsigned x = xb_xcc_id();
        __builtin_amdgcn_s_waitcnt(0);
        unsigned nloc = st[0], nx = st[1];
        if (nloc == 0u) { xcd_barrier_complete(bar, x, G, nloc, nx); st[0] = nloc; st[1] = nx;
            bool even = (nx == 8u);
#pragma unroll
            for (unsigned j = 0; j < 8; ++j) even = even && (xb_ld(&bar[XB_XCNT(j)]) * 8u == G);
            st[4] = even ? 1u : 0u; }
        const unsigned old = xb_add(&bar[XB_XSUB(x)], 1u);
        const unsigned gen = old / nloc;
        if (old + 1u == (gen + 1u) * nloc) {
            __builtin_amdgcn_fence(__ATOMIC_RELEASE, "agent");
            asm volatile("buffer_inv sc1" ::: "memory");
            asm volatile("s_waitcnt vmcnt(0)" ::: "memory");
            const unsigned og = xb_add(&bar[XB_TOP], 1u);
            const unsigned tg = og / nx;
            if (og + 1u == (tg + 1u) * nx) xb_add(&bar[XB_TOPGEN], 1u);
            else XB_SPIN(xb_ld(&bar[XB_TOPGEN]) == tg, bar);
            xb_add(&bar[XB_XGEN(x)], 1u);
            asm volatile("s_waitcnt vmcnt(0)" ::: "memory");
        } else {
            asm volatile("buffer_inv sc1" ::: "memory");
            XB_SPIN(xb_ld(&bar[XB_XGEN(x)]) == gen, bar);
            asm volatile("s_waitcnt vmcnt(0)" ::: "memory");
        }
    }
    __syncthreads();
}

constexpr int PPL = 10;
constexpr int N_PHASES = 3 + DEPTH * PPL;
__global__ void __launch_bounds__(NTHREADS, 2) mk_fwd(Params prm) {
    extern __shared__ __attribute__((aligned(16))) unsigned char lds_raw[];
    { const unsigned* src = (const unsigned*)&prm; LAS unsigned* dst = (LAS unsigned*)((LAS unsigned char*)lds_raw + PARAM_LDS_OFF);
      for (int i = threadIdx.x; i < (int)(sizeof(Params) / 4); i += NTHREADS) dst[i] = src[i]; }
    volatile LAS unsigned* bar_st = (volatile LAS unsigned*)((LAS unsigned char*)lds_raw + 131072 + 512);
    if (threadIdx.x == 0) { bar_st[0] = 0u; bar_st[1] = 0u; bar_st[2] = 0u; bar_st[3] = 0u; bar_st[4] = 0u; }
    __syncthreads();
    const int ph_lo = prm.ph_lo, ph_hi = prm.ph_hi + prm.rc, rp = prm.rp, rc = prm.rc;
    if (ph_hi - ph_lo > 1 && threadIdx.x == 0) { const unsigned x = xb_xcc_id(); bar_st[2] = xb_add((unsigned*)(prm.ws + WS_CTL) + XB_XCNT(x), 1u); bar_st[3] = x; }
    for (int it = ph_lo; it < ph_hi; ++it) {
        const int ph = (it <= rp) ? it : (it <= rp + rc ? rp : it - rc);
        int tid_ = threadIdx.x, bid_ = blockIdx.x, G_ = gridDim.x;
        int lz_ = 0; asm volatile("" : "+s"(lz_));
        volatile LAS unsigned* bst = bar_st + lz_;
        if (bst[4] != 0u) bid_ = (int)(bst[2] * 8u + bst[3]);
        bid_ = __builtin_amdgcn_readfirstlane(bid_);
        PL p; p.b = (LAS const unsigned char*)lds_raw + PARAM_LDS_OFF + lz_; asm volatile("" ::: "memory");

        unsigned char* ws = (unsigned char*)p.ldp((int)offsetof(Params, ws)); float* outp = (float*)p.ldp((int)offsetof(Params, out));
        asm volatile("" : "+v"(tid_)); asm volatile("" : "+s"(bid_)); asm volatile("" : "+s"(G_));
        Ctx c;
        c.lds = (LAS unsigned char*)lds_raw; c.tid = tid_; c.lane = tid_ & 63; c.wave = __builtin_amdgcn_readfirstlane(tid_ >> 6);
        c.bid = bid_; c.G = G_; c.gw = bid_ * NWAVES + c.wave; c.NGW = G_ * NWAVES;
        const int G = G_;
        bf16* H = (bf16*)(ws + WS_H); bf16* Y = (bf16*)(ws + WS_Y); bf16* A2 = (bf16*)(ws + WS_A2); bf16* T = (bf16*)(ws + WS_T);
        bf16* MG = (bf16*)(ws + WS_MG); bf16* ACT = (bf16*)(ws + WS_ACT); float* XS = (float*)(ws + WS_XS); bf16* XB = (bf16*)(ws + WS_XB);
        const float* modb = (const float*)(ws + WS_MOD);
        float* yp = outp + O_YP; float* ys = outp + O_YS;
        if (ph == 0) phase_A(p, c, ws);
        else if (ph == 1) modsum_phase(p, c, ws);
        else if (ph == 2) rownorm_phase(c, p.x_prompt(), nullptr, p.x_sample(), nullptr, nullptr, nullptr, 0, nullptr, nullptr, nullptr, p.norm_g(), modb, 0, 1, H);
        else {
            const int l = (ph - 3) / PPL, spx = (ph - 3) % PPL, sp = spx <= 1 ? spx : spx - 1;
            const float* mod = modb + (size_t)l * NB * N_MOD * D_MODEL;
            const float* ng = p.norm_g() + (size_t)l * 4 * D_MODEL;
            const bf16* WTin = (const bf16*)(ws + WS_WTIN + l * SZ_WTIN); const bf16* WTbr = (const bf16*)(ws + WS_WTBR + l * SZ_WTBR);
            const bf16* WTo = (const bf16*)(ws + WS_WTO + l * SZ_WTO); const bf16* WTup = (const bf16*)(ws + WS_WTUP + l * SZ_WTUP); const bf16* WTdn = (const bf16*)(ws + WS_WTDN + l * SZ_WTDN);
            pg8::StaticOrder S;
            if (spx == 2) {
                attn_combine_phase(c, (const bf16*)(ws + WS_OG), (const float*)(ws + WS_LSE), A2);
            } else if (sp == 0) {
                pg8::Gemm g{H, WTin, MP, N_IN - 256, D_MODEL, D_MODEL, D_MODEL}; S.init(g, G, c.bid);
                pg8::EpiBf16 E{Y, N_IN, c.lds};
                const int nb = ((0x5320 >> (4 * ((c.bid >> 3) & 3))) & 15) * c.NGW;
                gemv8(c, c.gw, c.NGW, H + (size_t)MP * D_MODEL, D_MODEL, D_MODEL, WTin, D_MODEL, nb < N_IN ? nb : N_IN, StBf16{Y + (size_t)MP * N_IN, N_IN});
                pg8::gemm_phase<pg8::EpiBf16, true>(c.lds, c.tid, g, S, E);
                gemv8(c, c.gw + nb, c.NGW, H + (size_t)MP * D_MODEL, D_MODEL, D_MODEL, WTin, D_MODEL, N_IN, StBf16{Y + (size_t)MP * N_IN, N_IN});
            } else if (sp == 1) {
                { pg8::Gemm g{H, WTin + (size_t)(N_IN - 256) * D_MODEL, MP, 256, D_MODEL, D_MODEL, D_MODEL}; S.init(g, G, c.bid);
                  pg8::EpiBf16 E{Y + (N_IN - 256), N_IN, c.lds};
                  pg8::gemm_phase<pg8::EpiBf16, true>(c.lds, c.tid, g, S, E); }
                mixer_phase(p, c, l, ws, outp);
            } else if (sp == 2) {
                const bool early = ((c.bid >> 3) & 1) != 0;
                if (early) gemv8_branch(c, A2 + (size_t)MP * K_BR, WTbr, Y + (size_t)MP * N_IN, MG + (size_t)MP * D_MODEL);
                { pg8::Gemm g{A2, WTbr, MP, D_MODEL, K_BR, K_BR, K_BR}; pg8::SegOrder S3; S3.init(g, c.bid);
                  pg8::EpiGate E{Y + OFF_GL, N_IN, MG, c.lds};
                  pg8::gemm_phase<pg8::EpiGate, true>(c.lds, c.tid, g, S3, E); }
                if (!early) gemv8_branch(c, A2 + (size_t)MP * K_BR, WTbr, Y + (size_t)MP * N_IN, MG + (size_t)MP * D_MODEL);
            } else if (sp == 3) {
                pg8::Gemm g{MG, WTo, MP, D_MODEL, D_MODEL, D_MODEL, D_MODEL}; S.init(g, G, c.bid);
                pg8::EpiBf16 E{T, D_MODEL, c.lds};
                const bool early = ((c.bid >> 3) & 1) != 0;
                if (early) gemv8(c, c.gw, c.NGW, MG + (size_t)MP * D_MODEL, D_MODEL, D_MODEL, WTo, D_MODEL, D_MODEL, StBf16{T + (size_t)MP * D_MODEL, D_MODEL});
                pg8::gemm_phase<pg8::EpiBf16, false>(c.lds, c.tid, g, S, E);
                if (!early) gemv8(c, c.gw, c.NGW, MG + (size_t)MP * D_MODEL, D_MODEL, D_MODEL, WTo, D_MODEL, D_MODEL, StBf16{T + (size_t)MP * D_MODEL, D_MODEL});
            } else if (sp == 4) {
                rownorm_phase(c, p.x_prompt(), l == 0 ? (const bf16*)nullptr : XB, l == 0 ? p.x_sample() : ys, T, ng + D_MODEL, mod, 2, nullptr, XB, XS, ng + 2 * D_MODEL, mod, 3, 4, H);
            } else if (sp == 5) {
                pg8::Gemm g{H, WTup, MP, N_UP, D_MODEL, D_MODEL, D_MODEL}; S.init(g, G, c.bid);
                EpiFfn E{ACT, Y, p.ffn_conv_w() + (size_t)l * 3 * N_UP};
                if (c.bid >= 128) gemv8(c, (c.bid - 128) * NWAVES + c.wave, (c.G - 128) * NWAVES, H + (size_t)MP * D_MODEL, D_MODEL, D_MODEL, WTup, D_MODEL, N_UP, StBf16Up{Y + (size_t)MP * N_UP});
                pg8::gemm_phase<EpiFfn, true>(c.lds, c.tid, g, S, E);
            } else if (sp == 6) {
                ffnact_phase(p, c, l, ws, outp);
            } else if (sp == 7) {
                pg8::Gemm g{ACT, WTdn, MP, D_MODEL, D_FF, D_FF, D_FF}; S.init(g, G, c.bid);
                pg8::EpiBf16 E{T, D_MODEL, c.lds};
                const bool early = ((c.bid >> 3) & 1) != 0;
                if (early) gemv8(c, c.gw, c.NGW, ACT + (size_t)MP * D_FF, D_FF, D_FF, WTdn, D_FF, D_MODEL, StBf16{T + (size_t)MP * D_MODEL, D_MODEL});
                pg8::gemm_phase<pg8::EpiBf16, false>(c.lds, c.tid, g, S, E);
                if (!early) gemv8(c, c.gw, c.NGW, ACT + (size_t)MP * D_FF, D_FF, D_FF, WTdn, D_FF, D_MODEL, StBf16{T + (size_t)MP * D_MODEL, D_MODEL});
            } else {
                const bool lastl = (l == DEPTH - 1);
                rownorm_phase(c, nullptr, XB, XS, T, ng + 3 * D_MODEL, mod, 5, yp, lastl ? (bf16*)nullptr : XB, ys, lastl ? nullptr : p.norm_g() + (size_t)(l + 1) * 4 * D_MODEL, modb + (size_t)(l + 1) * NB * N_MOD * D_MODEL, 0, 1, H);
            }
        }
        if (it + 1 < ph_hi) xcd_barrier((unsigned*)(ws + WS_CTL), bst, (unsigned)G_);
    }
}

extern "C" void kernel_launch(void* const* d_in, const int* in_sizes, int n_in, void* d_out, int out_size, void* d_ws, size_t ws_size, hipStream_t stream) {
    static int grid = 0;
    if (grid == 0) {
        if (n_in != 25 || (size_t)out_size != O_END || ws_size < WS_END) { fprintf(stderr, "kernel_launch: unexpected sizes n_in %d out %d (want %zu) ws %zu (want %zu)\n", n_in, out_size, (size_t)O_END, ws_size, (size_t)WS_END); grid = -1; return; }
        int dev = 0, cus = 0, per_cu = 0;
        hipGetDevice(&dev); hipDeviceGetAttribute(&cus, hipDeviceAttributeMultiprocessorCount, dev);
        if (hipFuncSetAttribute((const void*)mk_fwd, hipFuncAttributeMaxDynamicSharedMemorySize, LDS_BYTES) != hipSuccess) { fprintf(stderr, "kernel_launch: hipFuncSetAttribute failed\n"); grid = -1; return; }
        hipOccupancyMaxActiveBlocksPerMultiprocessor(&per_cu, (const void*)mk_fwd, NTHREADS, LDS_BYTES);
        if (per_cu < 1) { fprintf(stderr, "kernel_launch: occupancy query says %d blocks per CU\n", per_cu); grid = -1; return; }
        grid = cus;
    }
    if (grid < 0) return;
    (void)hipMemsetAsync((char*)d_ws + WS_CTL, 0, 16384, stream);
    Params p{};
    const float** pp = &p.x_prompt;
    for (int i = 0; i < 25; ++i) pp[i] = (const float*)d_in[i];
    p.out = (float*)d_out; p.ws = (unsigned char*)d_ws;
    for (int g = 0; g < 3; ++g) { const int dil = (g == 0) ? 1 : (g == 1 ? 4 : 16);
        for (int n = 0; n <= 128; ++n) { const int dist = n * dil; int bucket;
            if (dist < 16) bucket = dist; else { const int large = 16 + (int)(std::log((double)dist / 16.0) / std::log(2048.0 / 16.0) * 16.0); bucket = large < 31 ? large : 31; }
            p.tab.b[g][n] = (unsigned char)bucket; } }
#if MK_PER_PHASE
    for (int ph = 0; ph < N_PHASES; ++ph) { p.ph_lo = ph; p.ph_hi = ph + 1; hipLaunchKernelGGL(mk_fwd, dim3(grid), dim3(NTHREADS), LDS_BYTES, stream, p); }
#else
    p.ph_lo = 0; p.ph_hi = N_PHASES; p.rp = PROBE_RP; p.rc = PROBE_RC;
    void* args[] = {&p};
    hipError_t e = hipLaunchCooperativeKernel((const void*)mk_fwd, dim3(grid), dim3(NTHREADS), args, LDS_BYTES, stream);
    if (e != hipSuccess) fprintf(stderr, "kernel_launch: cooperative launch failed: %s\n", hipGetErrorString(e));
#endif
}
```
